# Optimizing an MI355X kernel written in HIP

```python
import math
import jax, jax.numpy as jnp
from jax import lax
import numpy as np

D_MODEL = 2048
BATCH = 4
SEQ = 2048
DEPTH = 1

SSM_WIDTH = D_MODEL // 2
SSM_GROUP = 16
SSM_GROUPS = SSM_WIDTH // SSM_GROUP
SSM_STATE = 64
ML_HEADS = 8
ML_HEAD_DIM = D_MODEL // 16
ML_WIDTH = ML_HEADS * ML_HEAD_DIM
ML_CHUNK = 64
QK_CONV = 4
PEER_HEADS = 8
PEER_NKEYS = 128
PEER_EXPERTS = PEER_NKEYS * PEER_NKEYS
PEER_QDIM = 256
PEER_HALF = PEER_QDIM // 2
PEER_TOPK = 16
PEER_TOKEN_BLOCK = 128
PLE_DIM = 256
IN_WIDTHS = (SSM_WIDTH, ML_WIDTH, ML_WIDTH, ML_WIDTH, ML_WIDTH, ML_HEADS, ML_HEADS, 2 * D_MODEL)
IN_WIDTH = sum(IN_WIDTHS)
LN_EPS = 1e-5
DN_ALPHA = (2 * DEPTH) ** 0.25
DN_BETA = (8 * DEPTH) ** -0.25

kernel_name = "hybrid_s5_mlstm_peer_deepnorm"


def layer_norm(x, g, b):
    xf = x.astype(jnp.float32)
    mu = jnp.mean(xf, axis=-1, keepdims=True)
    var = jnp.mean(jnp.square(xf - mu), axis=-1, keepdims=True)
    y = (xf - mu) * lax.rsqrt(var + LN_EPS) * g.astype(jnp.float32) + b.astype(jnp.float32)
    return y.astype(x.dtype)


def causal_conv(x, w):
    k_len = w.shape[0]
    s = x.shape[1]
    xp = jnp.pad(x, ((0, 0), (k_len - 1, 0), (0, 0)))
    out = xp[:, 0:s] * w[0]
    for j in range(1, k_len):
        out = out + xp[:, j:j + s] * w[j]
    return out


def _complex_linear_combine(e1, e2):
    a1r, a1i, b1r, b1i = e1
    a2r, a2i, b2r, b2i = e2
    return (a2r * a1r - a2i * a1i,
            a2r * a1i + a2i * a1r,
            a2r * b1r - a2i * b1i + b2r,
            a2r * b1i + a2i * b1r + b2i)


def s5_branch(u, a_re, a_im, log_dt, b_re, b_im, c_re, c_im, d_skip, w_glu, b_glu):
    bsz, s, _ = u.shape
    f32 = jnp.float32
    uf = u.astype(f32)
    ar, ai = a_re.astype(f32), a_im.astype(f32)
    dt = jnp.exp(log_dt.astype(f32))[:, None]
    mag = jnp.exp(dt * ar)
    lam_r = mag * jnp.cos(dt * ai)
    lam_i = mag * jnp.sin(dt * ai)
    den = ar * ar + ai * ai
    zr = ((lam_r - 1.0) * ar + lam_i * ai) / den
    zi = (lam_i * ar - (lam_r - 1.0) * ai) / den
    br, bi = b_re.astype(f32), b_im.astype(f32)
    bbar_r = zr[..., None] * br - zi[..., None] * bi
    bbar_i = zr[..., None] * bi + zi[..., None] * br
    ug = uf.reshape(bsz, s, SSM_GROUPS, SSM_GROUP)
    bu_r = jnp.einsum('bsgc,gpc->bsgp', ug, bbar_r)
    bu_i = jnp.einsum('bsgc,gpc->bsgp', ug, bbar_i)
    lr = jnp.broadcast_to(lam_r, bu_r.shape)
    li = jnp.broadcast_to(lam_i, bu_r.shape)
    _, _, st_r, st_i = lax.associative_scan(_complex_linear_combine, (lr, li, bu_r, bu_i), axis=1)
    y = (jnp.einsum('gcp,bsgp->bsgc', c_re.astype(f32), st_r)
         - jnp.einsum('gcp,bsgp->bsgc', c_im.astype(f32), st_i))
    y = y.reshape(bsz, s, SSM_WIDTH) + d_skip.astype(f32) * uf
    y = jax.nn.gelu(y)
    y = y * jax.nn.sigmoid(y @ w_glu.astype(f32) + b_glu.astype(f32))
    return y.astype(u.dtype)


def mlstm_chunkwise(q, k, v, i_pre, f_pre):
    bsz, s, nh, dh = q.shape
    nc = s // ML_CHUNK
    f32 = jnp.float32

    def to_chunks(t):
        return t.astype(f32).reshape(bsz, nc, ML_CHUNK, nh, -1).transpose(0, 3, 1, 2, 4)

    qc = to_chunks(q)
    kc = to_chunks(k) / math.sqrt(dh)
    vc = to_chunks(v)
    ig = i_pre.astype(f32).reshape(bsz, nc, ML_CHUNK, nh).transpose(0, 3, 1, 2)
    logf = jax.nn.log_sigmoid(f_pre.astype(f32)).reshape(bsz, nc, ML_CHUNK, nh).transpose(0, 3, 1, 2)
    bcum = jnp.cumsum(logf, axis=-1)
    gtot = bcum[..., -1]

    causal = jnp.tril(jnp.ones((ML_CHUNK, ML_CHUNK), dtype=bool))
    dmat = bcum[..., :, None] - bcum[..., None, :] + ig[..., None, :]
    dmat = jnp.where(causal, dmat, -jnp.inf)

    wlog = gtot[..., None] - bcum + ig
    m_loc = jnp.max(wlog, axis=-1)
    wts = jnp.exp(wlog - m_loc[..., None])
    c_chunk = jnp.einsum('bhcl,bhcld,bhcle->bhcde', wts, kc, vc)
    n_chunk = jnp.einsum('bhcl,bhcld->bhcd', wts, kc)

    def step(carry, xs):
        c_st, n_st, m_st = carry
        g_c, ml_c, cc_c, nc_c = xs
        m_new = jnp.maximum(g_c + m_st, ml_c)
        a = jnp.exp(g_c + m_st - m_new)
        bb = jnp.exp(ml_c - m_new)
        c_new = a[..., None, None] * c_st + bb[..., None, None] * cc_c
        n_new = a[..., None] * n_st + bb[..., None] * nc_c
        return (c_new, n_new, m_new), (c_st, n_st, m_st)

    init = (jnp.zeros((bsz, nh, dh, dh), f32), jnp.zeros((bsz, nh, dh), f32), jnp.zeros((bsz, nh), f32))
    xs = (jnp.moveaxis(gtot, 2, 0), jnp.moveaxis(m_loc, 2, 0),
          jnp.moveaxis(c_chunk, 2, 0), jnp.moveaxis(n_chunk, 2, 0))
    _, (c_prev, n_prev, m_prev) = lax.scan(step, init, xs)
    c_prev = jnp.moveaxis(c_prev, 0, 2)
    n_prev = jnp.moveaxis(n_prev, 0, 2)
    m_prev = jnp.moveaxis(m_prev, 0, 2)

    inter_log = bcum + m_prev[..., None]
    m_row = jnp.maximum(inter_log, jnp.max(dmat, axis=-1))
    pw = jnp.exp(dmat - m_row[..., None])
    sc = jnp.einsum('bhcld,bhcsd->bhcls', qc, kc) * pw
    inter_scale = jnp.exp(inter_log - m_row)
    num = (jnp.einsum('bhcls,bhcse->bhcle', sc, vc)
           + inter_scale[..., None] * jnp.einsum('bhcld,bhcde->bhcle', qc, c_prev))
    den = jnp.sum(sc, axis=-1) + inter_scale * jnp.einsum('bhcld,bhcd->bhcl', qc, n_prev)
    h = num / jnp.maximum(jnp.abs(den), jnp.exp(-m_row))[..., None]
    h = h.transpose(0, 2, 3, 1, 4).reshape(bsz, s, nh, dh)
    return h


def head_norm(h, w):
    hf = h.astype(jnp.float32)
    mu = jnp.mean(hf, axis=-1, keepdims=True)
    var = jnp.mean(jnp.square(hf - mu), axis=-1, keepdims=True)
    y = (hf - mu) * lax.rsqrt(var + LN_EPS) * w.astype(jnp.float32).reshape(ML_HEADS, ML_HEAD_DIM)
    return y


def token_mixer(h, w_in, b_igate, b_fgate, conv_qk, mh_norm_w, a_re, a_im, log_dt, b_re, b_im,
                c_re, c_im, d_skip, w_glu, b_glu, w_up_ssm, w_up_ml, w_out):
    bsz, s, _ = h.shape
    z = h @ w_in
    bounds = list(np.cumsum(IN_WIDTHS)[:-1])
    u, q, k, v, o, ig, fg, gates = jnp.split(z, bounds, axis=-1)
    y_a = s5_branch(u, a_re, a_im, log_dt, b_re, b_im, c_re, c_im, d_skip, w_glu, b_glu)
    qk = jax.nn.silu(causal_conv(jnp.concatenate([q, k], axis=-1), conv_qk))
    q, k = jnp.split(qk, 2, axis=-1)
    shp = (bsz, s, ML_HEADS, ML_HEAD_DIM)
    hm = mlstm_chunkwise(q.reshape(shp), k.reshape(shp), v.reshape(shp), ig + b_igate, fg + b_fgate)
    hm = head_norm(hm, mh_norm_w).reshape(bsz, s, ML_WIDTH)
    y_b = (jax.nn.sigmoid(o.astype(jnp.float32)) * hm).astype(h.dtype)
    g_a, g_b = jnp.split(jax.nn.sigmoid(gates), 2, axis=-1)
    merged = g_a * (y_a @ w_up_ssm) + g_b * (y_b @ w_up_ml)
    return merged @ w_out


def peer(h, wq, keys, u_tab, v_tab):
    bsz, s, d = h.shape
    t = bsz * s
    xt = h.reshape(t, d)
    qh = (xt @ wq).reshape(t, PEER_HEADS, 2, PEER_HALF)
    sc = jnp.einsum('thjd,hjnd->thjn', qh, keys).astype(jnp.float32)
    s1, i1 = lax.top_k(sc[:, :, 0], PEER_TOPK)
    s2, i2 = lax.top_k(sc[:, :, 1], PEER_TOPK)
    cand = (s1[..., :, None] + s2[..., None, :]).reshape(t, PEER_HEADS, PEER_TOPK * PEER_TOPK)
    cidx = (i1[..., :, None] * PEER_NKEYS + i2[..., None, :]).reshape(t, PEER_HEADS, PEER_TOPK * PEER_TOPK)
    top_s, pos = lax.top_k(cand, PEER_TOPK)
    eidx = jnp.take_along_axis(cidx, pos, axis=-1)
    gate = jax.nn.softmax(top_s, axis=-1).astype(h.dtype)
    nb = t // PEER_TOKEN_BLOCK

    def block(args):
        xb, eb, gb = args
        ub = jnp.take(u_tab, eb, axis=0)
        vb = jnp.take(v_tab, eb, axis=0)
        act = jax.nn.gelu(jnp.einsum('td,thkd->thk', xb, ub)) * gb
        return jnp.einsum('thk,thkd->td', act, vb)

    out = lax.map(block, (xt.reshape(nb, PEER_TOKEN_BLOCK, d),
                          eidx.reshape(nb, PEER_TOKEN_BLOCK, PEER_HEADS, PEER_TOPK),
                          gate.reshape(nb, PEER_TOKEN_BLOCK, PEER_HEADS, PEER_TOPK)))
    return out.reshape(bsz, s, d)


def setup_inputs(seed: int = 0) -> dict:
    key = jax.random.key(seed)
    ks = jax.random.split(key, 32)
    f32 = jnp.float32

    def nrm(k, shape, scale):
        return jax.random.normal(k, shape, f32) * scale

    L = DEPTH
    a_im_base = jnp.pi * jnp.arange(SSM_STATE, dtype=f32)
    return {
        "x": nrm(ks[0], (BATCH, SEQ, D_MODEL), 1.0),
        "p": nrm(ks[1], (DEPTH, BATCH, SEQ, PLE_DIM), 1.0),
        "w_in": nrm(ks[2], (L, D_MODEL, IN_WIDTH), D_MODEL ** -0.5),
        "b_igate": nrm(ks[3], (L, ML_HEADS), 0.1),
        "b_fgate": jnp.linspace(3.0, 6.0, ML_HEADS, dtype=f32)[None] + nrm(ks[4], (L, ML_HEADS), 0.1),
        "conv_qk": nrm(ks[5], (L, QK_CONV, 2 * ML_WIDTH), QK_CONV ** -0.5),
        "mh_norm_w": 1.0 + nrm(ks[6], (L, ML_WIDTH), 0.02),
        "ssm_a_re": -0.5 + nrm(ks[7], (L, SSM_GROUPS, SSM_STATE), 0.01),
        "ssm_a_im": a_im_base[None, None] + nrm(ks[8], (L, SSM_GROUPS, SSM_STATE), 0.01),
        "ssm_log_dt": jax.random.uniform(ks[9], (L, SSM_GROUPS), f32, math.log(1e-3), math.log(1e-1)),
        "ssm_b_re": nrm(ks[10], (L, SSM_GROUPS, SSM_STATE, SSM_GROUP), (2 * SSM_GROUP) ** -0.5),
        "ssm_b_im": nrm(ks[11], (L, SSM_GROUPS, SSM_STATE, SSM_GROUP), (2 * SSM_GROUP) ** -0.5),
        "ssm_c_re": nrm(ks[12], (L, SSM_GROUPS, SSM_GROUP, SSM_STATE), SSM_STATE ** -0.5),
        "ssm_c_im": nrm(ks[13], (L, SSM_GROUPS, SSM_GROUP, SSM_STATE), SSM_STATE ** -0.5),
        "ssm_d": nrm(ks[14], (L, SSM_WIDTH), 1.0),
        "w_glu": nrm(ks[15], (L, SSM_WIDTH, SSM_WIDTH), SSM_WIDTH ** -0.5),
        "b_glu": nrm(ks[16], (L, SSM_WIDTH), 0.01),
        "w_up_ssm": nrm(ks[17], (L, SSM_WIDTH, D_MODEL), SSM_WIDTH ** -0.5),
        "w_up_ml": nrm(ks[18], (L, ML_WIDTH, D_MODEL), ML_WIDTH ** -0.5),
        "w_out": nrm(ks[19], (L, D_MODEL, D_MODEL), DN_BETA * D_MODEL ** -0.5),
        "ln1_g": 1.0 + nrm(ks[20], (L, D_MODEL), 0.02),
        "ln1_b": nrm(ks[21], (L, D_MODEL), 0.02),
        "peer_wq": nrm(ks[22], (L, D_MODEL, PEER_HEADS * PEER_QDIM), D_MODEL ** -0.5),
        "peer_keys": nrm(ks[23], (L, PEER_HEADS, 2, PEER_NKEYS, PEER_HALF), PEER_HALF ** -0.5),
        "peer_u": nrm(ks[24], (L, PEER_EXPERTS, D_MODEL), D_MODEL ** -0.5),
        "peer_v": nrm(ks[25], (L, PEER_EXPERTS, D_MODEL), DN_BETA * PEER_HEADS ** -0.5),
        "ln2_g": 1.0 + nrm(ks[26], (L, D_MODEL), 0.02),
        "ln2_b": nrm(ks[27], (L, D_MODEL), 0.02),
        "ple_w_gate": nrm(ks[28], (L, D_MODEL, D_MODEL), D_MODEL ** -0.5),
        "ple_w_proj": nrm(ks[29], (L, PLE_DIM, D_MODEL), PLE_DIM ** -0.5),
    }


def reference(x, p, w_in, b_igate, b_fgate, conv_qk, mh_norm_w, ssm_a_re, ssm_a_im, ssm_log_dt,
              ssm_b_re, ssm_b_im, ssm_c_re, ssm_c_im, ssm_d, w_glu, b_glu, w_up_ssm, w_up_ml,
              w_out, ln1_g, ln1_b, peer_wq, peer_keys, peer_u, peer_v, ln2_g, ln2_b,
              ple_w_gate, ple_w_proj):
    h = x
    for i in range(DEPTH):
        y = token_mixer(h, w_in[i], b_igate[i], b_fgate[i], conv_qk[i], mh_norm_w[i],
                        ssm_a_re[i], ssm_a_im[i], ssm_log_dt[i], ssm_b_re[i], ssm_b_im[i],
                        ssm_c_re[i], ssm_c_im[i], ssm_d[i], w_glu[i], b_glu[i],
                        w_up_ssm[i], w_up_ml[i], w_out[i])
        h = layer_norm(DN_ALPHA * h + y, ln1_g[i], ln1_b[i])
        y = peer(h, peer_wq[i], peer_keys[i], peer_u[i], peer_v[i])
        h = layer_norm(DN_ALPHA * h + y, ln2_g[i], ln2_b[i])
        h = h + jax.nn.sigmoid(h @ ple_w_gate[i]) * (p[i] @ ple_w_proj[i])
    return h
```

```cpp
#include <hip/hip_runtime.h>
#include <hip/hip_bf16.h>
#include <hip/hip_cooperative_groups.h>
#include <cstdio>
namespace cg = cooperative_groups;

typedef unsigned short u16;
using bf16x8 = __attribute__((ext_vector_type(8))) short;
using f32x4 = __attribute__((ext_vector_type(4))) float;

#ifndef COOP_LAUNCH
#define COOP_LAUNCH 0
#endif

constexpr int T_TOK = 8192;
constexpr int DM = 2048;
constexpr int NWIN = 9344;
constexpr float DN_ALPHA = 1.189207115002721f;
constexpr int SMEM_BYTES = 73728;

constexpr size_t OFF_WIN  = 0;
constexpr size_t OFF_WGLU = OFF_WIN  + (size_t)NWIN * 2048 * 2;
constexpr size_t OFF_WUPS = OFF_WGLU + (size_t)1024 * 1024 * 2;
constexpr size_t OFF_WUPM = OFF_WUPS + (size_t)2048 * 1024 * 2;
constexpr size_t OFF_WOUT = OFF_WUPM + (size_t)2048 * 1024 * 2;
constexpr size_t OFF_WQ   = OFF_WOUT + (size_t)2048 * 2048 * 2;
constexpr size_t OFF_WPG  = OFF_WQ   + (size_t)2048 * 2048 * 2;
constexpr size_t OFF_WPP  = OFF_WPG  + (size_t)2048 * 2048 * 2;
constexpr size_t OFF_KEYS = OFF_WPP  + (size_t)2048 * 256 * 2;
constexpr size_t OFF_UB   = OFF_KEYS + (size_t)8 * 2 * 128 * 128 * 2;
constexpr size_t OFF_VB   = OFF_UB   + (size_t)16384 * 2048 * 2;
constexpr size_t OFF_S5P  = OFF_VB   + (size_t)16384 * 2048 * 2;
constexpr size_t OFF_PB   = OFF_S5P  + (size_t)(4096 * 2 + 65536 * 2) * 4;
constexpr size_t OFF_IF   = OFF_PB   + (size_t)T_TOK * 256 * 2;
constexpr size_t OFF_A0   = OFF_IF   + (size_t)T_TOK * 16 * 4;
constexpr size_t OFF_A1   = OFF_A0   + (size_t)T_TOK * 2048 * 2;
constexpr size_t OFF_A2   = OFF_A1   + (size_t)T_TOK * 1024 * 4;
constexpr size_t OFF_A3   = OFF_A2   + (size_t)T_TOK * 4096 * 2;
constexpr size_t OFF_A4   = OFF_A3   + (size_t)T_TOK * 4096 * 2;
constexpr size_t OFF_END  = OFF_A4   + (size_t)T_TOK * 4096 * 2;
constexpr size_t A4_HM    = (size_t)T_TOK * 1024 * 2;
constexpr size_t A4_TOPI  = (size_t)T_TOK * 256 * 4;
constexpr size_t A4_H2B   = (size_t)T_TOK * 1024 * 2;

struct Params {
  const float *x, *p, *w_in, *b_ig, *b_fg, *conv_qk, *mh_norm_w, *a_re, *a_im, *log_dt, *b_re, *b_im,
      *c_re, *c_im, *ssm_d, *w_glu, *b_glu, *w_up_ssm, *w_up_ml, *w_out, *ln1_g, *ln1_b, *peer_wq,
      *peer_keys, *peer_u, *peer_v, *ln2_g, *ln2_b, *ple_wg, *ple_wp;
  float* out;
  char* ws;
};

__device__ __forceinline__ u16 f2bf(float f) {
  unsigned u = __float_as_uint(f);
  u += 0x7fffu + ((u >> 16) & 1u);
  return (u16)(u >> 16);
}
__device__ __forceinline__ float bf2f(u16 h) { return __uint_as_float(((unsigned)h) << 16); }
__device__ __forceinline__ unsigned pack2(float a, float b) { return (unsigned)f2bf(a) | ((unsigned)f2bf(b) << 16); }
__device__ __forceinline__ float bflo(unsigned u) { return __uint_as_float(u << 16); }
__device__ __forceinline__ float bfhi(unsigned u) { return __uint_as_float(u & 0xffff0000u); }
__device__ __forceinline__ float sigmoidf_(float x) { return 1.f / (1.f + __expf(-x)); }
__device__ __forceinline__ float gelu_tanh(float x) {
  float u = 0.7978845608028654f * (x + 0.044715f * x * x * x);
  float t = 1.f - 2.f / (1.f + __expf(2.f * u));
  return 0.5f * x * (1.f + t);
}
__device__ __forceinline__ float wave_sum(float v) {
#pragma unroll
  for (int o = 32; o >= 1; o >>= 1) v += __shfl_xor(v, o);
  return v;
}
__device__ __forceinline__ float wave_max(float v) {
#pragma unroll
  for (int o = 32; o >= 1; o >>= 1) v = fmaxf(v, __shfl_xor(v, o));
  return v;
}
__device__ __forceinline__ f32x4 mfma16(bf16x8 a, bf16x8 b, f32x4 c) {
  return __builtin_amdgcn_mfma_f32_16x16x32_bf16(a, b, c, 0, 0, 0);
}

__device__ __forceinline__ void gemm_mainloop(f32x4 (&acc)[4][4], const u16* __restrict__ A, int lda,
                                              const u16* __restrict__ Bt, int ldb, int K, char* smem) {
  u16* As = (u16*)smem;
  u16* Bs = As + 2 * 128 * 72;
  const int tid = threadIdx.x, lane = tid & 63, wave = tid >> 6, wm = wave >> 1, wn = wave & 1;
  const int lr = tid >> 3, lc = (tid & 7) * 8;
  uint4 ra[4], rb[4];
#pragma unroll
  for (int i = 0; i < 4; ++i) {
    ra[i] = *(const uint4*)(A + (size_t)(lr + i * 32) * lda + lc);
    rb[i] = *(const uint4*)(Bt + (size_t)(lr + i * 32) * ldb + lc);
  }
#pragma unroll
  for (int i = 0; i < 4; ++i) {
    *(uint4*)(As + (lr + i * 32) * 72 + lc) = ra[i];
    *(uint4*)(Bs + (lr + i * 32) * 72 + lc) = rb[i];
  }
  __syncthreads();
  const int nk = K >> 6;
  for (int kt = 0; kt < nk; ++kt) {
    const int buf = kt & 1;
    if (kt + 1 < nk) {
      const int k0 = (kt + 1) << 6;
#pragma unroll
      for (int i = 0; i < 4; ++i) {
        ra[i] = *(const uint4*)(A + (size_t)(lr + i * 32) * lda + k0 + lc);
        rb[i] = *(const uint4*)(Bt + (size_t)(lr + i * 32) * ldb + k0 + lc);
      }
    }
    const u16* Ab = As + buf * 128 * 72;
    const u16* Bb = Bs + buf * 128 * 72;
#pragma unroll
    for (int ks = 0; ks < 2; ++ks) {
      bf16x8 af[4], bfr[4];
#pragma unroll
      for (int mi = 0; mi < 4; ++mi)
        af[mi] = *(const bf16x8*)(Ab + (wm * 64 + mi * 16 + (lane & 15)) * 72 + ks * 32 + (lane >> 4) * 8);
#pragma unroll
      for (int ni = 0; ni < 4; ++ni)
        bfr[ni] = *(const bf16x8*)(Bb + (wn * 64 + ni * 16 + (lane & 15)) * 72 + ks * 32 + (lane >> 4) * 8);
#pragma unroll
      for (int mi = 0; mi < 4; ++mi)
#pragma unroll
        for (int ni = 0; ni < 4; ++ni) acc[mi][ni] = mfma16(af[mi], bfr[ni], acc[mi][ni]);
    }
    if (kt + 1 < nk) {
      u16* An = As + (buf ^ 1) * 128 * 72;
      u16* Bn = Bs + (buf ^ 1) * 128 * 72;
#pragma unroll
      for (int i = 0; i < 4; ++i) {
        *(uint4*)(An + (lr + i * 32) * 72 + lc) = ra[i];
        *(uint4*)(Bn + (lr + i * 32) * 72 + lc) = rb[i];
      }
    }
    __syncthreads();
  }
}

__device__ __forceinline__ void zero_acc(f32x4 (&acc)[4][4]) {
#pragma unroll
  for (int i = 0; i < 4; ++i)
#pragma unroll
    for (int j = 0; j < 4; ++j) acc[i][j] = f32x4{0.f, 0.f, 0.f, 0.f};
}

__device__ __forceinline__ int opaque0() {
  int z;
  asm volatile("v_mov_b32 %0, 0" : "=v"(z));
  return z;
}
#define EPI_LOOP_BEGIN {                                                        \
  const int lz = lane + opaque0();                                              \
  _Pragma("unroll") for (int mi = 0; mi < 4; ++mi)                              \
  _Pragma("unroll") for (int ni = 0; ni < 4; ++ni)                              \
  _Pragma("unroll") for (int j = 0; j < 4; ++j) {                               \
    const int lrow = wm * 64 + mi * 16 + (lz >> 4) * 4 + j;                     \
    const int lcol = wn * 64 + ni * 16 + (lz & 15);
#define EPI_LOOP_END } }

__device__ void transpose_cvt(const float* __restrict__ src, int K, int N, u16* __restrict__ dst, int Npad,
                              int mode, char* smem) {
  float* tile = (float*)smem;
  const int tid = threadIdx.x;
  const int nkt = K / 64, nnt = Npad / 64;
  for (int u = blockIdx.x; u < nkt * nnt; u += gridDim.x) {
    const int kt = u % nkt, nt = u / nkt;
    const int k0 = kt * 64, n0 = nt * 64;
#pragma unroll 4
    for (int i = 0; i < 16; ++i) {
      int e = tid + i * 256;
      int kk = e >> 6, nn = e & 63;
      int n = n0 + nn, sc = n;
      if (mode == 1) sc = n < 5120 ? n : (n < 9216 ? n + 16 : (n < 9232 ? n - 9216 + 5120 : -1));
      float v = sc >= 0 ? src[(size_t)(k0 + kk) * N + sc] : 0.f;
      tile[kk * 65 + nn] = v;
    }
    __syncthreads();
#pragma unroll 4
    for (int i = 0; i < 16; ++i) {
      int e = tid + i * 256;
      int nn = e >> 6, kk = e & 63;
      dst[(size_t)(n0 + nn) * K + k0 + kk] = f2bf(tile[kk * 65 + nn]);
    }
    __syncthreads();
  }
}

__device__ void cvt_straight(const float* __restrict__ src, u16* __restrict__ dst, size_t n) {
  const size_t n4 = n >> 2;
  for (size_t i = (size_t)blockIdx.x * 256 + threadIdx.x; i < n4; i += (size_t)gridDim.x * 256) {
    float4 v = ((const float4*)src)[i];
    uint2 o;
    o.x = pack2(v.x, v.y);
    o.y = pack2(v.z, v.w);
    ((uint2*)dst)[i] = o;
  }
}

__device__ void phase0(const Params& P, char* smem) {
  char* ws = P.ws;
  transpose_cvt(P.w_in, 2048, 9232, (u16*)(ws + OFF_WIN), NWIN, 1, smem);
  transpose_cvt(P.w_glu, 1024, 1024, (u16*)(ws + OFF_WGLU), 1024, 0, smem);
  transpose_cvt(P.w_up_ssm, 1024, 2048, (u16*)(ws + OFF_WUPS), 2048, 0, smem);
  transpose_cvt(P.w_up_ml, 1024, 2048, (u16*)(ws + OFF_WUPM), 2048, 0, smem);
  transpose_cvt(P.w_out, 2048, 2048, (u16*)(ws + OFF_WOUT), 2048, 0, smem);
  transpose_cvt(P.peer_wq, 2048, 2048, (u16*)(ws + OFF_WQ), 2048, 0, smem);
  transpose_cvt(P.ple_wg, 2048, 2048, (u16*)(ws + OFF_WPG), 2048, 0, smem);
  transpose_cvt(P.ple_wp, 256, 2048, (u16*)(ws + OFF_WPP), 2048, 0, smem);
  cvt_straight(P.peer_keys, (u16*)(ws + OFF_KEYS), (size_t)8 * 2 * 128 * 128);
  cvt_straight(P.peer_u, (u16*)(ws + OFF_UB), (size_t)16384 * 2048);
  cvt_straight(P.peer_v, (u16*)(ws + OFF_VB), (size_t)16384 * 2048);
  cvt_straight(P.x, (u16*)(ws + OFF_A0), (size_t)T_TOK * 2048);
  cvt_straight(P.p, (u16*)(ws + OFF_PB), (size_t)T_TOK * 256);
  float* lam_r = (float*)(ws + OFF_S5P);
  float* lam_i = lam_r + 4096;
  float* bbar_r = lam_i + 4096;
  float* bbar_i = bbar_r + 65536;
  for (int i = blockIdx.x * 256 + threadIdx.x; i < 4096; i += gridDim.x * 256) {
    const int g = i >> 6;
    const double ar = P.a_re[i], ai = P.a_im[i];
    const double dt = (double)expf(P.log_dt[g]);
    const double mag = (double)expf((float)(dt * ar));
    const double ang = dt * ai;
    const double kq = rint(ang * 0.15915494309189535);
    const float red = (float)(ang - kq * 6.283185307179586);
    const double lr = mag * (double)cosf(red), li = mag * (double)sinf(red);
    const double den = ar * ar + ai * ai;
    const double zr = ((lr - 1.0) * ar + li * ai) / den;
    const double zi = (li * ar - (lr - 1.0) * ai) / den;
    lam_r[i] = (float)lr;
    lam_i[i] = (float)li;
#pragma unroll 4
    for (int c = 0; c < 16; ++c) {
      const double br = P.b_re[i * 16 + c], bi = P.b_im[i * 16 + c];
      bbar_r[i * 16 + c] = (float)(zr * br - zi * bi);
      bbar_i[i * 16 + c] = (float)(zr * bi + zi * br);
    }
  }
}

__device__ void phase1(const Params& P, char* smem) {
  char* ws = P.ws;
  const u16* xb = (const u16*)(ws + OFF_A0);
  const u16* wt = (const u16*)(ws + OFF_WIN);
  float* us = (float*)(ws + OFF_A1);
  u16* qkvo = (u16*)(ws + OFF_A2);
  u16* gates = (u16*)(ws + OFF_A3);
  float* ifg = (float*)(ws + OFF_IF);
  const int tid = threadIdx.x, lane = tid & 63, wave = tid >> 6, wm = wave >> 1, wn = wave & 1;
  const int ntn = NWIN / 128;
  for (int tile = blockIdx.x; tile < 64 * ntn; tile += gridDim.x) {
    const int mt = tile & 63, nt = tile >> 6;
    const int m0 = mt * 128, n0 = nt * 128;
    f32x4 acc[4][4];
    zero_acc(acc);
    gemm_mainloop(acc, xb + (size_t)m0 * 2048, 2048, wt + (size_t)n0 * 2048, 2048, 2048, smem);
    if (n0 < 1024) {
      EPI_LOOP_BEGIN
        us[(size_t)(m0 + lrow) * 1024 + n0 + lcol] = acc[mi][ni][j];
      EPI_LOOP_END
    } else if (n0 < 4096) {
      EPI_LOOP_BEGIN
        qkvo[(size_t)(m0 + lrow) * 4096 + (n0 - 1024) + lcol] = f2bf(acc[mi][ni][j]);
      EPI_LOOP_END
    } else if (n0 < 5120) {
      EPI_LOOP_BEGIN
        qkvo[(size_t)(m0 + lrow) * 4096 + (n0 - 1024) + lcol] = f2bf(sigmoidf_(acc[mi][ni][j]));
      EPI_LOOP_END
    } else if (n0 < 9216) {
      EPI_LOOP_BEGIN
        gates[(size_t)(m0 + lrow) * 4096 + (n0 - 5120) + lcol] = f2bf(sigmoidf_(acc[mi][ni][j]));
      EPI_LOOP_END
    } else {
      EPI_LOOP_BEGIN
        if (lcol < 16) {
          float bias = lcol < 8 ? P.b_ig[lcol] : P.b_fg[lcol - 8];
          ifg[(size_t)(m0 + lrow) * 16 + lcol] = acc[mi][ni][j] + bias;
        }
      EPI_LOOP_END
    }
  }
}

__device__ void s5_unit(const Params& P, int unit, char* smem) {
  char* ws = P.ws;
  const int tid = threadIdx.x, lane = tid & 63, wave = tid >> 6;
  const int b = unit >> 4, g = (unit & 15) * 4 + wave;
  float* BU = (float*)(smem + wave * 12544);
  u16* Sb = (u16*)(smem + wave * 12544 + 8192);
  const float* us = (const float*)(ws + OFF_A1);
  u16* yg = (u16*)(ws + OFF_A4);
  const float* lam_r = (const float*)(ws + OFF_S5P);
  const float* lam_i = lam_r + 4096;
  const float* bbar_r = lam_i + 4096;
  const float* bbar_i = bbar_r + 65536;
  const int l15 = lane & 15, lq = lane >> 4;
  bf16x8 bfr[8];
#pragma unroll
  for (int nt = 0; nt < 8; ++nt) {
    const int n = nt * 16 + l15;
    bf16x8 v = {0, 0, 0, 0, 0, 0, 0, 0};
    if (lq < 2) {
      const float* src = (n < 64) ? (bbar_r + ((size_t)(g * 64 + n) * 16 + lq * 8))
                                  : (bbar_i + ((size_t)(g * 64 + n - 64) * 16 + lq * 8));
#pragma unroll
      for (int jj = 0; jj < 8; ++jj) v[jj] = (short)f2bf(src[jj]);
    }
    bfr[nt] = v;
  }
  bf16x8 cfr[4];
#pragma unroll
  for (int ks = 0; ks < 4; ++ks) {
    const int nb = ks * 32 + lq * 8;
    bf16x8 v;
#pragma unroll
    for (int jj = 0; jj < 8; ++jj) {
      const int n = nb + jj;
      float val = (n < 64) ? P.c_re[(size_t)(g * 16 + l15) * 64 + n] : -P.c_im[(size_t)(g * 16 + l15) * 64 + (n - 64)];
      v[jj] = (short)f2bf(val);
    }
    cfr[ks] = v;
  }
  const float dsk = P.ssm_d[g * 16 + l15];
  const float lr = lam_r[g * 64 + lane], li = lam_i[g * 64 + lane];
  float sr = 0.f, si = 0.f;
  for (int sc = 0; sc < 128; ++sc) {
    const int t0 = b * 2048 + sc * 16;
    {
      bf16x8 af = {0, 0, 0, 0, 0, 0, 0, 0};
      if (lq < 2) {
        const float* src = us + (size_t)(t0 + l15) * 1024 + g * 16 + lq * 8;
        float4 v0 = *(const float4*)src, v1 = *(const float4*)(src + 4);
        af[0] = (short)f2bf(v0.x); af[1] = (short)f2bf(v0.y); af[2] = (short)f2bf(v0.z); af[3] = (short)f2bf(v0.w);
        af[4] = (short)f2bf(v1.x); af[5] = (short)f2bf(v1.y); af[6] = (short)f2bf(v1.z); af[7] = (short)f2bf(v1.w);
      }
#pragma unroll
      for (int nt = 0; nt < 8; ++nt) {
        f32x4 a = mfma16(af, bfr[nt], f32x4{0.f, 0.f, 0.f, 0.f});
#pragma unroll
        for (int jj = 0; jj < 4; ++jj) BU[(lq * 4 + jj) * 128 + nt * 16 + l15] = a[jj];
      }
    }
    __builtin_amdgcn_fence(__ATOMIC_RELEASE, "wavefront");
    __builtin_amdgcn_wave_barrier();
    __builtin_amdgcn_fence(__ATOMIC_ACQUIRE, "wavefront");
#pragma unroll
    for (int t = 0; t < 16; ++t) {
      const float br_ = BU[t * 128 + lane], bi_ = BU[t * 128 + 64 + lane];
      const float nsr = lr * sr - li * si + br_;
      const float nsi = lr * si + li * sr + bi_;
      sr = nsr; si = nsi;
      Sb[t * 136 + lane] = f2bf(sr);
      Sb[t * 136 + 64 + lane] = f2bf(si);
    }
    __builtin_amdgcn_fence(__ATOMIC_RELEASE, "wavefront");
    __builtin_amdgcn_wave_barrier();
    __builtin_amdgcn_fence(__ATOMIC_ACQUIRE, "wavefront");
    {
      f32x4 a = {0.f, 0.f, 0.f, 0.f};
#pragma unroll
      for (int ks = 0; ks < 4; ++ks) {
        bf16x8 af = *(const bf16x8*)(Sb + l15 * 136 + ks * 32 + lq * 8);
        a = mfma16(af, cfr[ks], a);
      }
#pragma unroll
      for (int jj = 0; jj < 4; ++jj) {
        const size_t t = (size_t)t0 + lq * 4 + jj;
        const float uu = us[t * 1024 + g * 16 + l15];
        const float y = a[jj] + dsk * uu;
        yg[t * 1024 + g * 16 + l15] = f2bf(gelu_tanh(y));
      }
    }
    __builtin_amdgcn_fence(__ATOMIC_RELEASE, "wavefront");
    __builtin_amdgcn_wave_barrier();
    __builtin_amdgcn_fence(__ATOMIC_ACQUIRE, "wavefront");
  }
  __syncthreads();
}

__device__ void mlstm_unit(const Params& P, int unit, char* smem) {
  char* ws = P.ws;
  const int b = unit >> 6, h = (unit >> 3) & 7, sl = unit & 7;
  u16* qs = (u16*)smem;
  u16* ks_ = qs + 64 * 136;
  u16* vT = ks_ + 64 * 136;
  u16* wvT = vT + 16 * 72;
  u16* scs = wvT + 16 * 72;
  u16* CT = scs + 64 * 72;
  float* fl = (float*)(CT + 16 * 136);
  float* es = fl;
  float* rts = fl + 64;
  float* isc = fl + 128;
  float* emr = fl + 192;
  float* wts = fl + 256;
  float* nst = fl + 320;
  float* qn = fl + 448;
  float* scal = fl + 512;
  const u16* qkvo = (const u16*)(ws + OFF_A2);
  const float* ifg = (const float*)(ws + OFF_IF);
  float* hm = (float*)(ws + OFF_A4 + A4_HM);
  const int tid = threadIdx.x, lane = tid & 63, wave = tid >> 6;
  const int l15 = lane & 15, lq = lane >> 4;
  const int dg = tid & 15, tseg = (tid >> 4) & 7, qk = tid >> 7;
  const int colbase = qk * 1024 + h * 128 + dg * 8;
  float cw[4][8];
#pragma unroll
  for (int j = 0; j < 4; ++j)
#pragma unroll
    for (int i = 0; i < 8; ++i) cw[j][i] = P.conv_qk[(size_t)j * 2048 + colbase + i];
  const float kscale = qk ? 0.08838834764831845f : 1.f;
  const int vs = tid >> 2, vdq = (tid & 3) * 4;
  for (int i = tid; i < 16 * 136; i += 256) CT[i] = 0;
  if (tid < 128) nst[tid] = 0.f;
  f32x4 stacc[2];
  stacc[0] = f32x4{0.f, 0.f, 0.f, 0.f};
  stacc[1] = f32x4{0.f, 0.f, 0.f, 0.f};
  float m_st = 0.f;
  __syncthreads();
  for (int chunk = 0; chunk < 32; ++chunk) {
    const int t0 = b * 2048 + chunk * 64;
    {
      float x0[8], x1[8], x2[8], x3[8];
      const int sp0 = chunk * 64 + tseg * 8;
      const u16* base = qkvo + (size_t)(b * 2048) * 4096 + colbase;
      auto ldrow = [&](int sp, float (&dst)[8]) {
        if (sp >= 0) {
          uint4 r = *(const uint4*)(base + (size_t)sp * 4096);
          dst[0] = bflo(r.x); dst[1] = bfhi(r.x); dst[2] = bflo(r.y); dst[3] = bfhi(r.y);
          dst[4] = bflo(r.z); dst[5] = bfhi(r.z); dst[6] = bflo(r.w); dst[7] = bfhi(r.w);
        } else {
#pragma unroll
          for (int i = 0; i < 8; ++i) dst[i] = 0.f;
        }
      };
      ldrow(sp0 - 3, x0);
      ldrow(sp0 - 2, x1);
      ldrow(sp0 - 1, x2);
#pragma unroll
      for (int r = 0; r < 8; ++r) {
        ldrow(sp0 + r, x3);
        float o[8];
#pragma unroll
        for (int i = 0; i < 8; ++i) {
          float c = cw[0][i] * x0[i] + cw[1][i] * x1[i] + cw[2][i] * x2[i] + cw[3][i] * x3[i];
          o[i] = c * sigmoidf_(c) * kscale;
        }
        uint4 w;
        w.x = pack2(o[0], o[1]); w.y = pack2(o[2], o[3]); w.z = pack2(o[4], o[5]); w.w = pack2(o[6], o[7]);
        u16* dstp = (qk ? ks_ : qs) + (tseg * 8 + r) * 136 + dg * 8;
        *(uint4*)dstp = w;
#pragma unroll
        for (int i = 0; i < 8; ++i) { x0[i] = x1[i]; x1[i] = x2[i]; x2[i] = x3[i]; }
      }
    }
    float vreg[4];
    {
      uint2 r = *(const uint2*)(qkvo + (size_t)(t0 + vs) * 4096 + 2048 + h * 128 + sl * 16 + vdq);
      vreg[0] = bflo(r.x); vreg[1] = bfhi(r.x); vreg[2] = bflo(r.y); vreg[3] = bfhi(r.y);
#pragma unroll
      for (int i = 0; i < 4; ++i) vT[(vdq + i) * 72 + vs] = f2bf(vreg[i]);
    }
    if (wave == 0) {
      const float ig = ifg[(size_t)(t0 + lane) * 16 + h];
      const float fp = ifg[(size_t)(t0 + lane) * 16 + 8 + h];
      const float logf = fminf(fp, 0.f) - log1pf(__expf(-fabsf(fp)));
      float bc = logf;
#pragma unroll
      for (int o = 1; o < 64; o <<= 1) {
        float n = __shfl_up(bc, o);
        if (lane >= o) bc += n;
      }
      const float gtot = __shfl(bc, 63);
      const float e = ig - bc;
      float pm = e;
#pragma unroll
      for (int o = 1; o < 64; o <<= 1) {
        float n = __shfl_up(pm, o);
        if (lane >= o) pm = fmaxf(pm, n);
      }
      const float mloc = gtot + __shfl(pm, 63);
      const float m_prev = m_st;
      const float m_new = fmaxf(gtot + m_prev, mloc);
      const float a = __expf(gtot + m_prev - m_new);
      const float wl = gtot + e;
      const float rt = -fmaxf(m_prev, pm);
      es[lane] = e;
      rts[lane] = rt;
      isc[lane] = __expf(m_prev + rt);
      emr[lane] = __expf(rt - bc);
      wts[lane] = __expf(wl - m_new);
      if (lane == 0) scal[0] = a;
      m_st = m_new;
    }
    __syncthreads();
#pragma unroll
    for (int i = 0; i < 4; ++i) wvT[(vdq + i) * 72 + vs] = f2bf(wts[vs] * vreg[i]);
    bf16x8 afr[4];
    f32x4 sacc[4];
#pragma unroll
    for (int ni = 0; ni < 4; ++ni) sacc[ni] = f32x4{0.f, 0.f, 0.f, 0.f};
#pragma unroll
    for (int kk = 0; kk < 4; ++kk) {
      afr[kk] = *(const bf16x8*)(qs + (wave * 16 + l15) * 136 + kk * 32 + lq * 8);
#pragma unroll
      for (int ni = 0; ni < 4; ++ni) {
        bf16x8 bb = *(const bf16x8*)(ks_ + (ni * 16 + l15) * 136 + kk * 32 + lq * 8);
        sacc[ni] = mfma16(afr[kk], bb, sacc[ni]);
      }
    }
    float rowsum[4];
#pragma unroll
    for (int jj = 0; jj < 4; ++jj) {
      const int t = wave * 16 + lq * 4 + jj;
      const float rt_t = rts[t];
      float rs = 0.f;
#pragma unroll
      for (int ni = 0; ni < 4; ++ni) {
        const int s = ni * 16 + l15;
        float val = (s <= t) ? sacc[ni][jj] * __expf(rt_t + es[s]) : 0.f;
        rs += val;
        scs[t * 72 + s] = f2bf(val);
      }
      rs += __shfl_xor(rs, 1);
      rs += __shfl_xor(rs, 2);
      rs += __shfl_xor(rs, 4);
      rs += __shfl_xor(rs, 8);
      rowsum[jj] = rs;
    }
    f32x4 cacc = {0.f, 0.f, 0.f, 0.f};
#pragma unroll
    for (int kk = 0; kk < 4; ++kk) {
      bf16x8 bb = *(const bf16x8*)(CT + l15 * 136 + kk * 32 + lq * 8);
      cacc = mfma16(afr[kk], bb, cacc);
    }
    {
      const int t = tid >> 2, part = tid & 3;
      float sacc1 = 0.f;
#pragma unroll 8
      for (int d = 0; d < 32; ++d) sacc1 += bf2f(qs[t * 136 + part * 32 + d]) * nst[part * 32 + d];
      sacc1 += __shfl_xor(sacc1, 1);
      sacc1 += __shfl_xor(sacc1, 2);
      if (part == 0) qn[t] = sacc1;
    }
    __syncthreads();
    {
      f32x4 nacc = {0.f, 0.f, 0.f, 0.f};
#pragma unroll
      for (int kk = 0; kk < 2; ++kk) {
        bf16x8 aa = *(const bf16x8*)(scs + (wave * 16 + l15) * 72 + kk * 32 + lq * 8);
        bf16x8 bb = *(const bf16x8*)(vT + l15 * 72 + kk * 32 + lq * 8);
        nacc = mfma16(aa, bb, nacc);
      }
#pragma unroll
      for (int jj = 0; jj < 4; ++jj) {
        const int t = wave * 16 + lq * 4 + jj;
        const float is = isc[t];
        const float num = nacc[jj] + is * cacc[jj];
        const float den = rowsum[jj] + is * qn[t];
        hm[(size_t)(t0 + t) * 1024 + h * 128 + sl * 16 + l15] = num / fmaxf(fabsf(den), emr[t]);
      }
    }
    {
      const float a = scal[0];
#pragma unroll
      for (int i = 0; i < 2; ++i) {
        const int sub = wave * 2 + i;
        f32x4 st = stacc[i];
        st[0] *= a; st[1] *= a; st[2] *= a; st[3] *= a;
#pragma unroll
        for (int kk = 0; kk < 2; ++kk) {
          bf16x8 aa = *(const bf16x8*)(wvT + l15 * 72 + kk * 32 + lq * 8);
          bf16x8 bb;
#pragma unroll
          for (int jj = 0; jj < 8; ++jj) bb[jj] = (short)ks_[(kk * 32 + lq * 8 + jj) * 136 + sub * 16 + l15];
          st = mfma16(aa, bb, st);
        }
        stacc[i] = st;
#pragma unroll
        for (int jj = 0; jj < 4; ++jj) CT[(lq * 4 + jj) * 136 + sub * 16 + l15] = f2bf(st[jj]);
      }
      if (tid < 128) {
        float acc = a * nst[tid];
#pragma unroll 8
        for (int s = 0; s < 64; ++s) acc += wts[s] * bf2f(ks_[s * 136 + tid]);
        nst[tid] = acc;
      }
    }
    __syncthreads();
  }
}

__device__ void phase2(const Params& P, char* smem) {
  for (int u = blockIdx.x; u < 320; u += gridDim.x) {
    if (u < 64) s5_unit(P, u, smem);
    else mlstm_unit(P, u - 64, smem);
  }
}

__device__ void phase3(const Params& P, char* smem) {
  char* ws = P.ws;
  const u16* yg = (const u16*)(ws + OFF_A4);
  const u16* wt = (const u16*)(ws + OFF_WGLU);
  u16* ya = (u16*)(ws + OFF_A1);
  u16* yb = ya + (size_t)T_TOK * 1024;
  const float* hm = (const float*)(ws + OFF_A4 + A4_HM);
  const u16* qkvo = (const u16*)(ws + OFF_A2);
  const int tid = threadIdx.x, lane = tid & 63, wave = tid >> 6, wm = wave >> 1, wn = wave & 1;
  for (int tile = blockIdx.x; tile < 64 * 8; tile += gridDim.x) {
    const int mt = tile & 63, nt = tile >> 6;
    const int m0 = mt * 128, n0 = nt * 128;
    f32x4 acc[4][4];
    zero_acc(acc);
    gemm_mainloop(acc, yg + (size_t)m0 * 1024, 1024, wt + (size_t)n0 * 1024, 1024, 1024, smem);
    EPI_LOOP_BEGIN
      const size_t idx = (size_t)(m0 + lrow) * 1024 + n0 + lcol;
      const float y = bf2f(yg[idx]);
      ya[idx] = f2bf(y * sigmoidf_(acc[mi][ni][j] + P.b_glu[n0 + lcol]));
    EPI_LOOP_END
  }
  for (int r = blockIdx.x * 4 + wave; r < T_TOK * 8; r += gridDim.x * 4) {
    const int t = r >> 3, hh = r & 7;
    const float* src = hm + (size_t)t * 1024 + hh * 128;
    const float v0 = src[lane], v1 = src[lane + 64];
    const float mean = wave_sum(v0 + v1) * (1.f / 128.f);
    const float d0 = v0 - mean, d1 = v1 - mean;
    const float var = wave_sum(d0 * d0 + d1 * d1) * (1.f / 128.f);
    const float rstd = rsqrtf(var + 1e-5f);
    const float o0 = bf2f(qkvo[(size_t)t * 4096 + 3072 + hh * 128 + lane]);
    const float o1 = bf2f(qkvo[(size_t)t * 4096 + 3072 + hh * 128 + lane + 64]);
    yb[(size_t)t * 1024 + hh * 128 + lane] = f2bf(o0 * d0 * rstd * P.mh_norm_w[hh * 128 + lane]);
    yb[(size_t)t * 1024 + hh * 128 + lane + 64] = f2bf(o1 * d1 * rstd * P.mh_norm_w[hh * 128 + lane + 64]);
  }
}

__device__ void phase4a(const Params& P, char* smem) {
  char* ws = P.ws;
  const u16* ya = (const u16*)(ws + OFF_A1);
  const u16* w1 = (const u16*)(ws + OFF_WUPS);
  const u16* gates = (const u16*)(ws + OFF_A3);
  float* tmpg = (float*)(ws + OFF_A4);
  const int tid = threadIdx.x, lane = tid & 63, wave = tid >> 6, wm = wave >> 1, wn = wave & 1;
  for (int tile = blockIdx.x; tile < 64 * 16; tile += gridDim.x) {
    const int mt = tile & 63, nt = tile >> 6;
    const int m0 = mt * 128, n0 = nt * 128;
    f32x4 acc[4][4];
    zero_acc(acc);
    gemm_mainloop(acc, ya + (size_t)m0 * 1024, 1024, w1 + (size_t)n0 * 1024, 1024, 1024, smem);
    EPI_LOOP_BEGIN
      const size_t row = (size_t)(m0 + lrow);
      const float ga = bf2f(gates[row * 4096 + n0 + lcol]);
      tmpg[row * 2048 + n0 + lcol] = ga * acc[mi][ni][j];
    EPI_LOOP_END
  }
}
__device__ void phase4b(const Params& P, char* smem) {
  char* ws = P.ws;
  const u16* yb = (const u16*)(ws + OFF_A1) + (size_t)T_TOK * 1024;
  const u16* w2 = (const u16*)(ws + OFF_WUPM);
  const u16* gates = (const u16*)(ws + OFF_A3);
  const float* tmpg = (const float*)(ws + OFF_A4);
  u16* merged = (u16*)(ws + OFF_A0);
  const int tid = threadIdx.x, lane = tid & 63, wave = tid >> 6, wm = wave >> 1, wn = wave & 1;
  for (int tile = blockIdx.x; tile < 64 * 16; tile += gridDim.x) {
    const int mt = tile & 63, nt = tile >> 6;
    const int m0 = mt * 128, n0 = nt * 128;
    f32x4 acc[4][4];
    zero_acc(acc);
    gemm_mainloop(acc, yb + (size_t)m0 * 1024, 1024, w2 + (size_t)n0 * 1024, 1024, 1024, smem);
    EPI_LOOP_BEGIN
      const size_t row = (size_t)(m0 + lrow);
      const float gb = bf2f(gates[row * 4096 + 2048 + n0 + lcol]);
      merged[row * 2048 + n0 + lcol] = f2bf(tmpg[row * 2048 + n0 + lcol] + gb * acc[mi][ni][j]);
    EPI_LOOP_END
  }
}

__device__ void phase5(const Params& P, char* smem) {
  char* ws = P.ws;
  const u16* merged = (const u16*)(ws + OFF_A0);
  const u16* wt = (const u16*)(ws + OFF_WOUT);
  float* r1 = (float*)(ws + OFF_A2);
  const int tid = threadIdx.x, lane = tid & 63, wave = tid >> 6, wm = wave >> 1, wn = wave & 1;
  for (int tile = blockIdx.x; tile < 64 * 16; tile += gridDim.x) {
    const int mt = tile & 63, nt = tile >> 6;
    const int m0 = mt * 128, n0 = nt * 128;
    f32x4 acc[4][4];
    zero_acc(acc);
    gemm_mainloop(acc, merged + (size_t)m0 * 2048, 2048, wt + (size_t)n0 * 2048, 2048, 2048, smem);
    EPI_LOOP_BEGIN
      const size_t idx = (size_t)(m0 + lrow) * 2048 + n0 + lcol;
      r1[idx] = DN_ALPHA * P.x[idx] + acc[mi][ni][j];
    EPI_LOOP_END
  }
}

__device__ void phase6(const Params& P, char* smem) {
  char* ws = P.ws;
  float* r1 = (float*)(ws + OFF_A2);
  u16* h1b = (u16*)(ws + OFF_A0);
  const int tid = threadIdx.x, lane = tid & 63, wave = tid >> 6;
  for (int r = blockIdx.x * 4 + wave; r < T_TOK; r += gridDim.x * 4) {
    float* row = r1 + (size_t)r * 2048;
    float v[32];
    float s = 0.f;
#pragma unroll
    for (int i = 0; i < 4; ++i) {
      float4 a = *(const float4*)(row + i * 512 + lane * 8);
      float4 c = *(const float4*)(row + i * 512 + lane * 8 + 4);
      v[i * 8 + 0] = a.x; v[i * 8 + 1] = a.y; v[i * 8 + 2] = a.z; v[i * 8 + 3] = a.w;
      v[i * 8 + 4] = c.x; v[i * 8 + 5] = c.y; v[i * 8 + 6] = c.z; v[i * 8 + 7] = c.w;
    }
#pragma unroll
    for (int i = 0; i < 32; ++i) s += v[i];
    const float mean = wave_sum(s) * (1.f / 2048.f);
    float q = 0.f;
#pragma unroll
    for (int i = 0; i < 32; ++i) { v[i] -= mean; q += v[i] * v[i]; }
    const float rstd = rsqrtf(wave_sum(q) * (1.f / 2048.f) + 1e-5f);
#pragma unroll
    for (int i = 0; i < 4; ++i) {
      const int c0 = i * 512 + lane * 8;
      float o[8];
#pragma unroll
      for (int jj = 0; jj < 8; ++jj) o[jj] = v[i * 8 + jj] * rstd * P.ln1_g[c0 + jj] + P.ln1_b[c0 + jj];
      *(float4*)(row + c0) = float4{o[0], o[1], o[2], o[3]};
      *(float4*)(row + c0 + 4) = float4{o[4], o[5], o[6], o[7]};
      uint4 w;
      w.x = pack2(o[0], o[1]); w.y = pack2(o[2], o[3]); w.z = pack2(o[4], o[5]); w.w = pack2(o[6], o[7]);
      *(uint4*)(h1b + (size_t)r * 2048 + c0) = w;
    }
  }
}

__device__ void phase7(const Params& P, char* smem) {
  char* ws = P.ws;
  const u16* h1b = (const u16*)(ws + OFF_A0);
  const u16* wt = (const u16*)(ws + OFF_WQ);
  const u16* keysb = (const u16*)(ws + OFF_KEYS);
  float* tops = (float*)(ws + OFF_A4);
  int* topi = (int*)(ws + OFF_A4 + A4_TOPI);
  const int tid = threadIdx.x, lane = tid & 63, wave = tid >> 6, wm = wave >> 1, wn = wave & 1;
  for (int tile = blockIdx.x; tile < 64 * 16; tile += gridDim.x) {
    const int mt = tile & 63, nt = tile >> 6;
    const int m0 = mt * 128, n0 = nt * 128;
    f32x4 acc[4][4];
    zero_acc(acc);
    gemm_mainloop(acc, h1b + (size_t)m0 * 2048, 2048, wt + (size_t)n0 * 2048, 2048, 2048, smem);
    u16* Q = (u16*)smem;
    u16* Kt = Q + 128 * 136;
    EPI_LOOP_BEGIN
      Q[lrow * 136 + lcol] = f2bf(acc[mi][ni][j]);
    EPI_LOOP_END
    {
      const u16* kb = keysb + (size_t)nt * 128 * 128;
#pragma unroll
      for (int i = 0; i < 8; ++i) {
        const int id = tid + i * 256;
        const int row = id >> 4, ch = id & 15;
        *(uint4*)(Kt + row * 136 + ch * 8) = *(const uint4*)(kb + row * 128 + ch * 8);
      }
    }
    __syncthreads();
    zero_acc(acc);
#pragma unroll
    for (int ks = 0; ks < 4; ++ks) {
      bf16x8 af[4], bfr[4];
#pragma unroll
      for (int mi = 0; mi < 4; ++mi)
        af[mi] = *(const bf16x8*)(Q + (wm * 64 + mi * 16 + (lane & 15)) * 136 + ks * 32 + (lane >> 4) * 8);
#pragma unroll
      for (int ni = 0; ni < 4; ++ni)
        bfr[ni] = *(const bf16x8*)(Kt + (wn * 64 + ni * 16 + (lane & 15)) * 136 + ks * 32 + (lane >> 4) * 8);
#pragma unroll
      for (int mi = 0; mi < 4; ++mi)
#pragma unroll
        for (int ni = 0; ni < 4; ++ni) acc[mi][ni] = mfma16(af[mi], bfr[ni], acc[mi][ni]);
    }
    __syncthreads();
    float* Sc = (float*)smem;
    EPI_LOOP_BEGIN
      Sc[lrow * 129 + lcol] = acc[mi][ni][j];
    EPI_LOOP_END
    __syncthreads();
    if (tid < 128) {
      float* r = Sc + tid * 129;
      const size_t ob = ((size_t)(m0 + tid) * 16 + nt) * 16;
      for (int k = 0; k < 16; ++k) {
        float best = -3.0e38f;
        int bi = 0;
#pragma unroll 8
        for (int c = 0; c < 128; ++c) {
          const float v = r[c];
          if (v > best) { best = v; bi = c; }
        }
        tops[ob + k] = best;
        topi[ob + k] = bi;
        r[bi] = -3.0e38f;
      }
    }
    __syncthreads();
  }
}

__device__ void phase9(const Params& P, char* smem) {
  char* ws = P.ws;
  const float* h1 = (const float*)(ws + OFF_A2);
  const float* tops = (const float*)(ws + OFF_A4);
  const int* topi = (const int*)(ws + OFF_A4 + A4_TOPI);
  const u16* Ub = (const u16*)(ws + OFF_UB);
  const u16* Vb = (const u16*)(ws + OFF_VB);
  float* h2 = (float*)(ws + OFF_A3);
  u16* h2b = (u16*)(ws + OFF_A4 + A4_H2B);
  float* red = (float*)smem;
  float* rsm = (float*)(smem + 32768);
  const int tid = threadIdx.x, lane = tid & 63, wave = tid >> 6;
  int ca, cb;
  {
    const int l = lane;
    if (l < 16) { ca = 0; cb = l; }
    else if (l < 24) { ca = 1; cb = l - 16; }
    else if (l < 29) { ca = 2; cb = l - 24; }
    else if (l < 33) { ca = 3; cb = l - 29; }
    else if (l < 36) { ca = 4; cb = l - 33; }
    else if (l < 38) { ca = 5; cb = l - 36; }
    else if (l < 40) { ca = 6; cb = l - 38; }
    else if (l < 42) { ca = 7; cb = l - 40; }
    else if (l < 50) { ca = l - 34; cb = 0; }
    else { ca = 0; cb = 0; }
  }
  const bool cvalid = lane < 50;
  for (int t = blockIdx.x; t < T_TOK; t += gridDim.x) {
    float xr[32];
    {
      const float* row = h1 + (size_t)t * 2048;
#pragma unroll
      for (int i = 0; i < 4; ++i) {
        float4 a = *(const float4*)(row + i * 512 + lane * 8);
        float4 c = *(const float4*)(row + i * 512 + lane * 8 + 4);
        xr[i * 8 + 0] = a.x; xr[i * 8 + 1] = a.y; xr[i * 8 + 2] = a.z; xr[i * 8 + 3] = a.w;
        xr[i * 8 + 4] = c.x; xr[i * 8 + 5] = c.y; xr[i * 8 + 6] = c.z; xr[i * 8 + 7] = c.w;
      }
    }
    float mysc = 0.f;
    int myidx = 0;
#pragma unroll
    for (int hh = 0; hh < 2; ++hh) {
      const int head = wave * 2 + hh;
      const size_t ob = ((size_t)t * 16 + head * 2) * 16;
      float val = -3.0e38f;
      int eid = 0;
      if (cvalid) {
        val = tops[ob + ca] + tops[ob + 16 + cb];
        eid = topi[ob + ca] * 128 + topi[ob + 16 + cb];
      }
      for (int k = 0; k < 16; ++k) {
        const float m = wave_max(val);
        const unsigned long long mask = __ballot(val == m);
        const int win = __ffsll((long long)mask) - 1;
        const int widx = __shfl(eid, win);
        if (lane == hh * 16 + k) { mysc = m; myidx = widx; }
        if (lane == win) val = -3.0e38f;
      }
    }
    float mygate;
    {
      float mx = mysc;
#pragma unroll
      for (int o = 8; o >= 1; o >>= 1) mx = fmaxf(mx, __shfl_xor(mx, o));
      const float e = __expf(mysc - mx);
      float sm = e;
#pragma unroll
      for (int o = 8; o >= 1; o >>= 1) sm += __shfl_xor(sm, o);
      mygate = e / sm;
    }
    float acc[32];
#pragma unroll
    for (int i = 0; i < 32; ++i) acc[i] = 0.f;
    for (int eb = 0; eb < 32; eb += 4) {
      int id[4];
      float gt[4];
#pragma unroll
      for (int q = 0; q < 4; ++q) { id[q] = __shfl(myidx, eb + q); gt[q] = __shfl(mygate, eb + q); }
      uint4 ur[4][4];
#pragma unroll
      for (int q = 0; q < 4; ++q)
#pragma unroll
        for (int i = 0; i < 4; ++i) ur[q][i] = *(const uint4*)(Ub + (size_t)id[q] * 2048 + i * 512 + lane * 8);
      uint4 vr[4][4];
#pragma unroll
      for (int q = 0; q < 4; ++q)
#pragma unroll
        for (int i = 0; i < 4; ++i) vr[q][i] = *(const uint4*)(Vb + (size_t)id[q] * 2048 + i * 512 + lane * 8);
      float d[4];
#pragma unroll
      for (int q = 0; q < 4; ++q) {
        float s = 0.f;
#pragma unroll
        for (int i = 0; i < 4; ++i) {
          s += xr[i * 8 + 0] * bflo(ur[q][i].x) + xr[i * 8 + 1] * bfhi(ur[q][i].x);
          s += xr[i * 8 + 2] * bflo(ur[q][i].y) + xr[i * 8 + 3] * bfhi(ur[q][i].y);
          s += xr[i * 8 + 4] * bflo(ur[q][i].z) + xr[i * 8 + 5] * bfhi(ur[q][i].z);
          s += xr[i * 8 + 6] * bflo(ur[q][i].w) + xr[i * 8 + 7] * bfhi(ur[q][i].w);
        }
        d[q] = s;
      }
#pragma unroll
      for (int o = 32; o >= 1; o >>= 1) {
#pragma unroll
        for (int q = 0; q < 4; ++q) d[q] += __shfl_xor(d[q], o);
      }
#pragma unroll
      for (int q = 0; q < 4; ++q) {
        const float a = gelu_tanh(d[q]) * gt[q];
#pragma unroll
        for (int i = 0; i < 4; ++i) {
          acc[i * 8 + 0] += a * bflo(vr[q][i].x); acc[i * 8 + 1] += a * bfhi(vr[q][i].x);
          acc[i * 8 + 2] += a * bflo(vr[q][i].y); acc[i * 8 + 3] += a * bfhi(vr[q][i].y);
          acc[i * 8 + 4] += a * bflo(vr[q][i].z); acc[i * 8 + 5] += a * bfhi(vr[q][i].z);
          acc[i * 8 + 6] += a * bflo(vr[q][i].w); acc[i * 8 + 7] += a * bfhi(vr[q][i].w);
        }
      }
    }
#pragma unroll
    for (int i = 0; i < 4; ++i) {
      float* dst = red + wave * 2048 + i * 512 + lane * 8;
      *(float4*)dst = float4{acc[i * 8 + 0], acc[i * 8 + 1], acc[i * 8 + 2], acc[i * 8 + 3]};
      *(float4*)(dst + 4) = float4{acc[i * 8 + 4], acc[i * 8 + 5], acc[i * 8 + 6], acc[i * 8 + 7]};
    }
    __syncthreads();
    float r[8];
    {
      const int c0 = tid * 8;
      const float* hrow = h1 + (size_t)t * 2048 + c0;
      float4 a = *(const float4*)hrow, c = *(const float4*)(hrow + 4);
      r[0] = a.x; r[1] = a.y; r[2] = a.z; r[3] = a.w; r[4] = c.x; r[5] = c.y; r[6] = c.z; r[7] = c.w;
#pragma unroll
      for (int jj = 0; jj < 8; ++jj) {
        r[jj] = DN_ALPHA * r[jj] + red[c0 + jj] + red[2048 + c0 + jj] + red[4096 + c0 + jj] + red[6144 + c0 + jj];
      }
      float s = 0.f;
#pragma unroll
      for (int jj = 0; jj < 8; ++jj) s += r[jj];
      s = wave_sum(s);
      if (lane == 0) rsm[wave] = s;
      __syncthreads();
      const float mean = (rsm[0] + rsm[1] + rsm[2] + rsm[3]) * (1.f / 2048.f);
      float q = 0.f;
#pragma unroll
      for (int jj = 0; jj < 8; ++jj) { r[jj] -= mean; q += r[jj] * r[jj]; }
      q = wave_sum(q);
      if (lane == 0) rsm[4 + wave] = q;
      __syncthreads();
      const float rstd = rsqrtf((rsm[4] + rsm[5] + rsm[6] + rsm[7]) * (1.f / 2048.f) + 1e-5f);
      float o[8];
#pragma unroll
      for (int jj = 0; jj < 8; ++jj) o[jj] = r[jj] * rstd * P.ln2_g[c0 + jj] + P.ln2_b[c0 + jj];
      float* orow = h2 + (size_t)t * 2048 + c0;
      *(float4*)orow = float4{o[0], o[1], o[2], o[3]};
      *(float4*)(orow + 4) = float4{o[4], o[5], o[6], o[7]};
      uint4 w;
      w.x = pack2(o[0], o[1]); w.y = pack2(o[2], o[3]); w.z = pack2(o[4], o[5]); w.w = pack2(o[6], o[7]);
      *(uint4*)(h2b + (size_t)t * 2048 + c0) = w;
    }
    __syncthreads();
  }
}

__device__ void phase10(const Params& P, char* smem) {
  char* ws = P.ws;
  const u16* h2b = (const u16*)(ws + OFF_A4 + A4_H2B);
  const float* h2 = (const float*)(ws + OFF_A3);
  const u16* pb = (const u16*)(ws + OFF_PB);
  const u16* wg = (const u16*)(ws + OFF_WPG);
  const u16* wp = (const u16*)(ws + OFF_WPP);
  const int tid = threadIdx.x, lane = tid & 63, wave = tid >> 6, wm = wave >> 1, wn = wave & 1;
  for (int tile = blockIdx.x; tile < 64 * 16; tile += gridDim.x) {
    const int mt = tile & 63, nt = tile >> 6;
    const int m0 = mt * 128, n0 = nt * 128;
    f32x4 acc[4][4], acc2[4][4];
    zero_acc(acc);
    zero_acc(acc2);
    gemm_mainloop(acc, h2b + (size_t)m0 * 2048, 2048, wg + (size_t)n0 * 2048, 2048, 2048, smem);
    gemm_mainloop(acc2, pb + (size_t)m0 * 256, 256, wp + (size_t)n0 * 256, 256, 256, smem);
    EPI_LOOP_BEGIN
      const size_t idx = (size_t)(m0 + lrow) * 2048 + n0 + lcol;
      P.out[idx] = h2[idx] + sigmoidf_(acc[mi][ni][j]) * acc2[mi][ni][j];
    EPI_LOOP_END
  }
}

constexpr int N_PHASES = 11;

template <int MODE>
__global__ void __launch_bounds__(256, 2) mega(Params P) {
  __shared__ __attribute__((aligned(16))) char smem[SMEM_BYTES];
#define RUN_PHASE(n, fn)                                              \
  if (MODE < 0 || MODE == n) {                                        \
    fn(P, smem);                                                      \
    if (MODE < 0 && n + 1 < N_PHASES) cg::this_grid().sync();         \
  }
  RUN_PHASE(0, phase0)
  RUN_PHASE(1, phase1)
  RUN_PHASE(2, phase2)
  RUN_PHASE(3, phase3)
  RUN_PHASE(4, phase4a)
  RUN_PHASE(5, phase4b)
  RUN_PHASE(6, phase5)
  RUN_PHASE(7, phase6)
  RUN_PHASE(8, phase7)
  RUN_PHASE(9, phase9)
  RUN_PHASE(10, phase10)
}

__global__ void dbg_dump(Params P, int which) {
  const size_t n = (size_t)T_TOK * 2048;
  for (size_t i = (size_t)blockIdx.x * 256 + threadIdx.x; i < n; i += (size_t)gridDim.x * 256) {
    const size_t t = i >> 11, c = i & 2047;
    float v = 0.f;
    if (which == 2) {
      const float* hm = (const float*)(P.ws + OFF_A4 + A4_HM);
      const u16* yg = (const u16*)(P.ws + OFF_A4);
      v = c < 1024 ? hm[t * 1024 + c] : bf2f(yg[t * 1024 + (c - 1024)]);
    } else if (which == 7) {
      v = ((const float*)(P.ws + OFF_A2))[i];
    } else if (which == 8) {
      const float* tops = (const float*)(P.ws + OFF_A4);
      const int* topi = (const int*)(P.ws + OFF_A4 + A4_TOPI);
      v = i < 2097152 ? tops[i] : (i < 4194304 ? (float)topi[i - 2097152] : 0.f);
    } else if (which == 9) {
      v = ((const float*)(P.ws + OFF_A3))[i];
    }
    P.out[i] = v;
  }
}

template <int PH>
static void launch_phase(const Params& P, hipStream_t stream) {
  hipLaunchKernelGGL(mega<PH>, dim3(512), dim3(256), 0, stream, P);
}

extern "C" void kernel_launch(void* const* d_in, const int* in_sizes, int n_in, void* d_out, int out_size,
                              void* d_ws, size_t ws_size, hipStream_t stream) {
  Params P{};
  const float** pp = (const float**)&P;
  for (int i = 0; i < 30; ++i) pp[i] = (const float*)d_in[i];
  P.out = (float*)d_out;
  P.ws = (char*)d_ws;
  if (ws_size < OFF_END) {
    fprintf(stderr, "workspace too small: %zu < %zu\n", ws_size, (size_t)OFF_END);
    return;
  }
#if COOP_LAUNCH
  static int grid_blocks = 0;
  if (!grid_blocks) {
    int dev = 0, cus = 0, per_cu = 0;
    hipGetDevice(&dev);
    hipDeviceGetAttribute(&cus, hipDeviceAttributeMultiprocessorCount, dev);
    hipOccupancyMaxActiveBlocksPerMultiprocessor(&per_cu, mega<-1>, 256, 0);
    grid_blocks = cus * per_cu;
  }
  void* args[] = {&P};
  hipError_t e = hipLaunchCooperativeKernel((void*)mega<-1>, dim3(grid_blocks), dim3(256), args, 0, stream);
  if (e != hipSuccess) fprintf(stderr, "cooperative launch failed: %s (grid %d)\n", hipGetErrorString(e), grid_blocks);
#else
#ifndef DEBUG_STOP
#define DEBUG_STOP 100
#endif
  launch_phase<0>(P, stream);
  launch_phase<1>(P, stream);
  launch_phase<2>(P, stream);
  if (DEBUG_STOP == 2) { hipLaunchKernelGGL(dbg_dump, dim3(1024), dim3(256), 0, stream, P, 2); return; }
  launch_phase<3>(P, stream);
  launch_phase<4>(P, stream);
  launch_phase<5>(P, stream);
  launch_phase<6>(P, stream);
  launch_phase<7>(P, stream);
  if (DEBUG_STOP == 7) { hipLaunchKernelGGL(dbg_dump, dim3(1024), dim3(256), 0, stream, P, 7); return; }
  launch_phase<8>(P, stream);
  if (DEBUG_STOP == 8) { hipLaunchKernelGGL(dbg_dump, dim3(1024), dim3(256), 0, stream, P, 8); return; }
  launch_phase<9>(P, stream);
  if (DEBUG_STOP == 9) { hipLaunchKernelGGL(dbg_dump, dim3(1024), dim3(256), 0, stream, P, 9); return; }
  launch_phase<10>(P, stream);
#endif
}
```

```cpp
#include <hip/hip_runtime.h>
#include <hip/hip_bf16.h>
#include <hip/hip_cooperative_groups.h>
#include <cstdio>
namespace cg = cooperative_groups;

typedef unsigned short u16;
using bf16x8 = __attribute__((ext_vector_type(8))) short;
using f32x4 = __attribute__((ext_vector_type(4))) float;
using f32x2 = __attribute__((ext_vector_type(2))) float;
typedef unsigned u32x4v __attribute__((ext_vector_type(4)));

#ifndef COOP_LAUNCH
#define COOP_LAUNCH 1
#endif

constexpr int T_TOK = 8192;
constexpr int DM = 2048;
constexpr int NWIN = 9344;
constexpr float DN_ALPHA = 1.189207115002721f;
constexpr int SMEM_BYTES = 73728 + 16;
constexpr float U_SCALE = 512.f, V_SCALE = 64.f;

constexpr size_t OFF_WIN  = 0;
constexpr size_t OFF_WGLU = OFF_WIN  + (size_t)NWIN * 2048 * 2;
constexpr size_t OFF_WUPS = OFF_WGLU + (size_t)1024 * 1024 * 2;
constexpr size_t OFF_WUPM = OFF_WUPS + (size_t)2048 * 1024 * 2;
constexpr size_t OFF_WOUT = OFF_WUPM + (size_t)2048 * 1024 * 2;
constexpr size_t OFF_WQ   = OFF_WOUT + (size_t)2048 * 2048 * 2;
constexpr size_t OFF_WPG  = OFF_WQ   + (size_t)2048 * 2048 * 2;
constexpr size_t OFF_WPP  = OFF_WPG  + (size_t)2048 * 2048 * 2;
constexpr size_t OFF_KEYS = OFF_WPP  + (size_t)2048 * 256 * 2;
constexpr size_t OFF_UB   = OFF_KEYS + (size_t)8 * 2 * 128 * 128 * 2;
constexpr size_t OFF_VB   = OFF_UB   + (size_t)16384 * 2048 * 2;
constexpr size_t OFF_S5P  = OFF_VB   + (size_t)16384 * 2048 * 2;
constexpr size_t OFF_PB   = OFF_S5P  + (size_t)(4096 * 2 + 65536 * 2) * 4;
constexpr size_t OFF_IF   = OFF_PB   + (size_t)T_TOK * 256 * 2;
constexpr size_t OFF_A0   = OFF_IF   + (size_t)T_TOK * 16 * 4;
constexpr size_t OFF_A1   = OFF_A0   + (size_t)T_TOK * 2048 * 2;
constexpr size_t OFF_A2   = OFF_A1   + (size_t)T_TOK * 1024 * 4;
constexpr size_t OFF_A3   = OFF_A2   + (size_t)T_TOK * 4096 * 2;
constexpr size_t OFF_A4   = OFF_A3   + (size_t)T_TOK * 4096 * 2;
constexpr size_t OFF_END  = OFF_A4   + (size_t)T_TOK * 4096 * 2;
constexpr size_t OFF_SP   = OFF_END;
constexpr int SP_BIG = 0, SP_BFG = 8, SP_CONV = 16, SP_MHW = SP_CONV + 8192, SP_CRE = SP_MHW + 1024, SP_CIM = SP_CRE + 65536,
              SP_SSMD = SP_CIM + 65536, SP_BGLU = SP_SSMD + 1024, SP_LN1G = SP_BGLU + 1024, SP_LN1B = SP_LN1G + 2048,
              SP_LN2G = SP_LN1B + 2048, SP_LN2B = SP_LN2G + 2048, SP_TOTAL = SP_LN2B + 2048;
constexpr size_t OFF_BAR  = ((OFF_SP + (size_t)SP_TOTAL * 4 + 255) / 256) * 256;
constexpr size_t OFF_TCTR = OFF_BAR + 3456 * 4;
constexpr size_t OFF_QKC  = OFF_TCTR + 256;
constexpr size_t OFF_END2 = OFF_QKC + (size_t)T_TOK * 2048 * 2;
constexpr size_t A4_HM    = (size_t)T_TOK * 1024 * 2;
constexpr size_t A4_TOPI  = (size_t)T_TOK * 256 * 4;
constexpr size_t A4_H2B   = (size_t)T_TOK * 1024 * 2;

struct Params {
  const float *x, *p, *w_in, *b_ig, *b_fg, *conv_qk, *mh_norm_w, *a_re, *a_im, *log_dt, *b_re, *b_im,
      *c_re, *c_im, *ssm_d, *w_glu, *b_glu, *w_up_ssm, *w_up_ml, *w_out, *ln1_g, *ln1_b, *peer_wq,
      *peer_keys, *peer_u, *peer_v, *ln2_g, *ln2_b, *ple_wg, *ple_wp;
  float* out;
  char* ws;
  int nblk;
  int pad_;
};

typedef __bf16 bf16x2_t __attribute__((ext_vector_type(2)));
__device__ __forceinline__ unsigned pack2(float a, float b) {
  const f32x2 v = {a, b};
  return __builtin_bit_cast(unsigned, __builtin_convertvector(v, bf16x2_t));
}
__device__ __forceinline__ u16 f2bf(float f) { return (u16)(pack2(f, 0.f) & 0xffffu); }
__device__ __forceinline__ float bf2f(u16 h) { return __uint_as_float(((unsigned)h) << 16); }
__device__ __forceinline__ float bflo(unsigned u) { return __uint_as_float(u << 16); }
__device__ __forceinline__ float bfhi(unsigned u) { return __uint_as_float(u & 0xffff0000u); }
__device__ __forceinline__ float sigmoidf_(float x) { return __builtin_amdgcn_rcpf(1.f + __expf(-x)); }
__device__ __forceinline__ float gelu_tanh(float x) {
  float u = 0.7978845608028654f * (x + 0.044715f * x * x * x);
  float t = 1.f - 2.f * __builtin_amdgcn_rcpf(1.f + __expf(2.f * u));
  return 0.5f * x * (1.f + t);
}
template <int CTRL> __device__ __forceinline__ float dpp_f(float v) {
  return __builtin_bit_cast(float, __builtin_amdgcn_update_dpp(0, __builtin_bit_cast(int, v), CTRL, 0xF, 0xF, false));
}
__device__ __forceinline__ float rdl(float v, int l) { return __builtin_bit_cast(float, __builtin_amdgcn_readlane(__builtin_bit_cast(int, v), l)); }
__device__ __forceinline__ float row_sum(float v) {
  v += dpp_f<0xB1>(v); v += dpp_f<0x4E>(v); v += dpp_f<0x141>(v); v += dpp_f<0x140>(v);
  return v;
}
__device__ __forceinline__ float row_max(float v) {
  v = fmaxf(v, dpp_f<0xB1>(v)); v = fmaxf(v, dpp_f<0x4E>(v)); v = fmaxf(v, dpp_f<0x141>(v)); v = fmaxf(v, dpp_f<0x140>(v));
  return v;
}
template <int CTRL, int ROWMASK> __device__ __forceinline__ float dpp_fm(float old, float v) {
  return __builtin_bit_cast(float, __builtin_amdgcn_update_dpp(__builtin_bit_cast(int, old), __builtin_bit_cast(int, v), CTRL, ROWMASK, 0xF, false));
}
__device__ __forceinline__ float wave_scan_sum(float v) {
  v += dpp_fm<0x111, 0xF>(0.f, v);
  v += dpp_fm<0x112, 0xF>(0.f, v);
  v += dpp_fm<0x114, 0xF>(0.f, v);
  v += dpp_fm<0x118, 0xF>(0.f, v);
  v += dpp_fm<0x142, 0xA>(0.f, v);
  v += dpp_fm<0x143, 0xC>(0.f, v);
  return v;
}
__device__ __forceinline__ float wave_scan_max(float v) {
  const float ninf = -3.0e38f;
  v = fmaxf(v, dpp_fm<0x111, 0xF>(ninf, v));
  v = fmaxf(v, dpp_fm<0x112, 0xF>(ninf, v));
  v = fmaxf(v, dpp_fm<0x114, 0xF>(ninf, v));
  v = fmaxf(v, dpp_fm<0x118, 0xF>(ninf, v));
  v = fmaxf(v, dpp_fm<0x142, 0xA>(ninf, v));
  v = fmaxf(v, dpp_fm<0x143, 0xC>(ninf, v));
  return v;
}
__device__ __forceinline__ float wave_sum(float v) {
  v = row_sum(v);
  return (rdl(v, 0) + rdl(v, 16)) + (rdl(v, 32) + rdl(v, 48));
}
__device__ __forceinline__ float wave_max(float v) {
  v = row_max(v);
  return fmaxf(fmaxf(rdl(v, 0), rdl(v, 16)), fmaxf(rdl(v, 32), rdl(v, 48)));
}
__device__ __forceinline__ f32x4 mfma16(bf16x8 a, bf16x8 b, f32x4 c) {
  return __builtin_amdgcn_mfma_f32_16x16x32_bf16(a, b, c, 0, 0, 0);
}

template <int DEPTH = 1>
__device__ __forceinline__ void gemm_mainloop(f32x4 (&acc)[4][4], const u16* __restrict__ A, int lda,
                                              const u16* __restrict__ Bt, int ldb, int K, char* smem) {
  u16* As = (u16*)smem;
  u16* Bs = As + 2 * 128 * 64;
  const int tid = threadIdx.x, lane = tid & 63, wave = tid >> 6, wm = wave >> 1, wn = wave & 1;
  const int lr = tid >> 3, lc = (tid & 7) * 8;
  const int lcs = ((tid & 7) ^ ((lr >> 1) & 7)) * 8;
  const int sw = (lane & 15) >> 1;
  const int fo0 = (lane & 15) * 64 + (((lane >> 4) ^ sw) * 8), fo1 = (lane & 15) * 64 + ((((lane >> 4) ^ sw) ^ 4) * 8);
  u32x4v ra0, ra1, ra2, ra3, rb0, rb1, rb2, rb3;
  u32x4v qa0, qa1, qa2, qa3, qb0, qb1, qb2, qb3;
  const __amdgpu_buffer_rsrc_t rsA = __builtin_amdgcn_make_buffer_rsrc((void*)A, 0, 0x7fffffff, 0x00020000);
  const __amdgpu_buffer_rsrc_t rsB = __builtin_amdgcn_make_buffer_rsrc((void*)Bt, 0, 0x7fffffff, 0x00020000);
  const int oa0 = (int)(((size_t)lr * lda + lc) * 2), oa1 = oa0 + 64 * lda, oa2 = oa0 + 128 * lda, oa3 = oa0 + 192 * lda;
  const int ob0 = (int)(((size_t)lr * ldb + lc) * 2), ob1 = ob0 + 64 * ldb, ob2 = ob0 + 128 * ldb, ob3 = ob0 + 192 * ldb;
#define GL_LOAD_X(k0) {                                                              \
  const int ko_ = (int)(k0) * 2;                                                     \
  ra0 = __builtin_amdgcn_raw_buffer_load_b128(rsA, oa0, ko_, 0); rb0 = __builtin_amdgcn_raw_buffer_load_b128(rsB, ob0, ko_, 0); \
  ra1 = __builtin_amdgcn_raw_buffer_load_b128(rsA, oa1, ko_, 0); rb1 = __builtin_amdgcn_raw_buffer_load_b128(rsB, ob1, ko_, 0); \
  ra2 = __builtin_amdgcn_raw_buffer_load_b128(rsA, oa2, ko_, 0); rb2 = __builtin_amdgcn_raw_buffer_load_b128(rsB, ob2, ko_, 0); \
  ra3 = __builtin_amdgcn_raw_buffer_load_b128(rsA, oa3, ko_, 0); rb3 = __builtin_amdgcn_raw_buffer_load_b128(rsB, ob3, ko_, 0); }
#define GL_LOAD_Y(k0) {                                                              \
  const int ko_ = (int)(k0) * 2;                                                     \
  qa0 = __builtin_amdgcn_raw_buffer_load_b128(rsA, oa0, ko_, 0); qb0 = __builtin_amdgcn_raw_buffer_load_b128(rsB, ob0, ko_, 0); \
  qa1 = __builtin_amdgcn_raw_buffer_load_b128(rsA, oa1, ko_, 0); qb1 = __builtin_amdgcn_raw_buffer_load_b128(rsB, ob1, ko_, 0); \
  qa2 = __builtin_amdgcn_raw_buffer_load_b128(rsA, oa2, ko_, 0); qb2 = __builtin_amdgcn_raw_buffer_load_b128(rsB, ob2, ko_, 0); \
  qa3 = __builtin_amdgcn_raw_buffer_load_b128(rsA, oa3, ko_, 0); qb3 = __builtin_amdgcn_raw_buffer_load_b128(rsB, ob3, ko_, 0); }
#define LDS_STORE_X(Ad, Bd)                                                          \
  *(u32x4v*)((Ad) + (lr) * 64 + lcs) = ra0;      *(u32x4v*)((Bd) + (lr) * 64 + lcs) = rb0;      \
  *(u32x4v*)((Ad) + (lr + 32) * 64 + lcs) = ra1; *(u32x4v*)((Bd) + (lr + 32) * 64 + lcs) = rb1; \
  *(u32x4v*)((Ad) + (lr + 64) * 64 + lcs) = ra2; *(u32x4v*)((Bd) + (lr + 64) * 64 + lcs) = rb2; \
  *(u32x4v*)((Ad) + (lr + 96) * 64 + lcs) = ra3; *(u32x4v*)((Bd) + (lr + 96) * 64 + lcs) = rb3;
#define LDS_STORE_Y(Ad, Bd)                                                          \
  *(u32x4v*)((Ad) + (lr) * 64 + lcs) = qa0;      *(u32x4v*)((Bd) + (lr) * 64 + lcs) = qb0;      \
  *(u32x4v*)((Ad) + (lr + 32) * 64 + lcs) = qa1; *(u32x4v*)((Bd) + (lr + 32) * 64 + lcs) = qb1; \
  *(u32x4v*)((Ad) + (lr + 64) * 64 + lcs) = qa2; *(u32x4v*)((Bd) + (lr + 64) * 64 + lcs) = qb2; \
  *(u32x4v*)((Ad) + (lr + 96) * 64 + lcs) = qa3; *(u32x4v*)((Bd) + (lr + 96) * 64 + lcs) = qb3;
#define MMA_STEP(Ab, Bb)                                                             \
  __builtin_amdgcn_s_setprio(1);                                                     \
  _Pragma("unroll") for (int ks = 0; ks < 2; ++ks) {                                 \
    bf16x8 af[4], bfr[4];                                                            \
    const int fo_ = ks ? fo1 : fo0;                                                  \
    _Pragma("unroll") for (int mi = 0; mi < 4; ++mi)                                 \
      af[mi] = *(const bf16x8*)((Ab) + (wm * 64 + mi * 16) * 64 + fo_);              \
    _Pragma("unroll") for (int ni = 0; ni < 4; ++ni)                                 \
      bfr[ni] = *(const bf16x8*)((Bb) + (wn * 64 + ni * 16) * 64 + fo_);             \
    _Pragma("unroll") for (int mi = 0; mi < 4; ++mi)                                 \
    _Pragma("unroll") for (int ni = 0; ni < 4; ++ni) acc[mi][ni] = mfma16(bfr[ni], af[mi], acc[mi][ni]); \
  }                                                                                  \
  __builtin_amdgcn_s_setprio(0);
  u16* As1 = As + 128 * 64;
  u16* Bs1 = Bs + 128 * 64;
  const int nk = K >> 6;
  if (DEPTH == 1) {
    GL_LOAD_X(0)
    LDS_STORE_X(As, Bs)
    __syncthreads();
    for (int kt = 0; kt < nk; kt += 2) {
      GL_LOAD_X((kt + 1) << 6)
      __builtin_amdgcn_sched_barrier(0);
      MMA_STEP(As, Bs)
      __builtin_amdgcn_sched_barrier(0);
      LDS_STORE_X(As1, Bs1)
      __syncthreads();
      if (kt + 2 < nk) { GL_LOAD_X((kt + 2) << 6) }
      __builtin_amdgcn_sched_barrier(0);
      MMA_STEP(As1, Bs1)
      __builtin_amdgcn_sched_barrier(0);
      if (kt + 2 < nk) { LDS_STORE_X(As, Bs) }
      __syncthreads();
    }
  } else {
    GL_LOAD_X(0)
    LDS_STORE_X(As, Bs)
    GL_LOAD_X(64)
    if (nk > 2) { GL_LOAD_Y(128) }
    __syncthreads();
    for (int kt = 0; kt < nk; kt += 2) {
      __builtin_amdgcn_sched_barrier(0);
      MMA_STEP(As, Bs)
      __builtin_amdgcn_sched_barrier(0);
      LDS_STORE_X(As1, Bs1)
      if (kt + 3 < nk) { GL_LOAD_X((kt + 3) << 6) }
      __syncthreads();
      __builtin_amdgcn_sched_barrier(0);
      MMA_STEP(As1, Bs1)
      __builtin_amdgcn_sched_barrier(0);
      if (kt + 2 < nk) { LDS_STORE_Y(As, Bs) }
      if (kt + 4 < nk) { GL_LOAD_Y((kt + 4) << 6) }
      __syncthreads();
    }
  }
#undef GL_LOAD_X
#undef GL_LOAD_Y
#undef LDS_STORE_X
#undef LDS_STORE_Y
#undef MMA_STEP
}

__device__ __forceinline__ void zero_acc(f32x4 (&acc)[4][4]) {
#pragma unroll
  for (int i = 0; i < 4; ++i)
#pragma unroll
    for (int j = 0; j < 4; ++j) acc[i][j] = f32x4{0.f, 0.f, 0.f, 0.f};
}

__device__ __forceinline__ int opaque0() {
  int z;
  asm volatile("v_mov_b32 %0, 0" : "=v"(z));
  return z;
}
#define EPIV_BEGIN {                                                            \
  const int lz = lane + opaque0();                                              \
  _Pragma("unroll") for (int mi = 0; mi < 4; ++mi) {
#define EPIV_INNER                                                              \
  _Pragma("unroll") for (int ni = 0; ni < 4; ++ni) {                            \
    const int lrow = wm * 64 + mi * 16 + (lz & 15);                             \
    const int lcol0 = wn * 64 + ni * 16 + (lz >> 4) * 4;
#define EPIV_INNER_END }
#define EPIV_MID __builtin_amdgcn_sched_barrier(0);
#define EPIV_END __builtin_amdgcn_sched_barrier(0); } }
__device__ __forceinline__ uint2 pack4(f32x4 v) { uint2 r; r.x = pack2(v[0], v[1]); r.y = pack2(v[2], v[3]); return r; }
__device__ __forceinline__ f32x4 unpack4(uint2 u) { return f32x4{bflo(u.x), bfhi(u.x), bflo(u.y), bfhi(u.y)}; }
__device__ __forceinline__ f32x4 sigmoid4(f32x4 v) { return f32x4{sigmoidf_(v[0]), sigmoidf_(v[1]), sigmoidf_(v[2]), sigmoidf_(v[3])}; }


__device__ __forceinline__ void gemm_mainloop_big(f32x4 (&acc)[8][4], const u16* __restrict__ A, int lda,
                                                  const u16* __restrict__ Bt, int ldb, int K, char* smem) {
  u16* As = (u16*)smem;
  u16* Bs = As + 2 * 256 * 32;
  const int tid = threadIdx.x, lane = tid & 63, wave = tid >> 6, wm = wave >> 1, wn = wave & 1;
  const int r4 = tid >> 2;
  const int lcs = ((tid & 3) ^ ((0 - (r4 >> 2)) & 3)) * 8;
  const int fo = (lane & 15) * 32 + (((lane >> 4) ^ ((0 - ((lane & 15) >> 2)) & 3)) * 8);
  const __amdgpu_buffer_rsrc_t rsA = __builtin_amdgcn_make_buffer_rsrc((void*)A, 0, 0x7fffffff, 0x00020000);
  const __amdgpu_buffer_rsrc_t rsB = __builtin_amdgcn_make_buffer_rsrc((void*)Bt, 0, 0x7fffffff, 0x00020000);
  const int oa0 = (r4 * lda + (tid & 3) * 8) * 2, oa1 = oa0 + 128 * lda, oa2 = oa0 + 256 * lda, oa3 = oa0 + 384 * lda;
  const int ob0 = (r4 * ldb + (tid & 3) * 8) * 2, ob1 = ob0 + 128 * ldb;
  u32x4v a0, a1, a2, a3, b0, b1;
#define BG_LOAD(k0) {                                                                \
  const int ko_ = (int)(k0) * 2;                                                     \
  a0 = __builtin_amdgcn_raw_buffer_load_b128(rsA, oa0, ko_, 0); b0 = __builtin_amdgcn_raw_buffer_load_b128(rsB, ob0, ko_, 0); \
  a1 = __builtin_amdgcn_raw_buffer_load_b128(rsA, oa1, ko_, 0); b1 = __builtin_amdgcn_raw_buffer_load_b128(rsB, ob1, ko_, 0); \
  a2 = __builtin_amdgcn_raw_buffer_load_b128(rsA, oa2, ko_, 0);                      \
  a3 = __builtin_amdgcn_raw_buffer_load_b128(rsA, oa3, ko_, 0); }
#define BG_STORE(Ad, Bd)                                                             \
  *(u32x4v*)((Ad) + (r4) * 32 + lcs) = a0;       *(u32x4v*)((Ad) + (r4 + 64) * 32 + lcs) = a1;  \
  *(u32x4v*)((Ad) + (r4 + 128) * 32 + lcs) = a2; *(u32x4v*)((Ad) + (r4 + 192) * 32 + lcs) = a3; \
  *(u32x4v*)((Bd) + (r4) * 32 + lcs) = b0;       *(u32x4v*)((Bd) + (r4 + 64) * 32 + lcs) = b1;
#define BG_MMA(Ab, Bb) {                                                             \
    __builtin_amdgcn_s_setprio(1);                                                   \
    bf16x8 bfr[4];                                                                   \
    _Pragma("unroll") for (int ni = 0; ni < 4; ++ni)                                 \
      bfr[ni] = *(const bf16x8*)((Bb) + (wn * 64 + ni * 16) * 32 + fo);              \
    _Pragma("unroll") for (int mh = 0; mh < 2; ++mh) {                               \
      bf16x8 af[4];                                                                  \
      _Pragma("unroll") for (int mi = 0; mi < 4; ++mi)                               \
        af[mi] = *(const bf16x8*)((Ab) + (wm * 128 + (mh * 4 + mi) * 16) * 32 + fo); \
      _Pragma("unroll") for (int mi = 0; mi < 4; ++mi)                               \
      _Pragma("unroll") for (int ni = 0; ni < 4; ++ni)                               \
        acc[mh * 4 + mi][ni] = mfma16(bfr[ni], af[mi], acc[mh * 4 + mi][ni]);        \
    }                                                                                \
    __builtin_amdgcn_s_setprio(0); }
  u16* As1 = As + 256 * 32;
  u16* Bs1 = Bs + 128 * 32;
  const int nk = K >> 5;
  BG_LOAD(0)
  BG_STORE(As, Bs)
  __syncthreads();
  for (int kt = 0; kt < nk; kt += 2) {
    BG_LOAD((kt + 1) << 5)
    __builtin_amdgcn_sched_barrier(0);
    BG_MMA(As, Bs)
    __builtin_amdgcn_sched_barrier(0);
    BG_STORE(As1, Bs1)
    __syncthreads();
    if (kt + 2 < nk) { BG_LOAD((kt + 2) << 5) }
    __builtin_amdgcn_sched_barrier(0);
    BG_MMA(As1, Bs1)
    __builtin_amdgcn_sched_barrier(0);
    if (kt + 2 < nk) { BG_STORE(As, Bs) }
    __syncthreads();
  }
#undef BG_LOAD
#undef BG_STORE
#undef BG_MMA
}
__device__ __forceinline__ void zero_acc8(f32x4 (&acc)[8][4]) {
#pragma unroll
  for (int i = 0; i < 8; ++i)
#pragma unroll
    for (int j = 0; j < 4; ++j) acc[i][j] = f32x4{0.f, 0.f, 0.f, 0.f};
}
#define EPIV8_BEGIN {                                                           \
  const int lz = lane + opaque0();                                              \
  _Pragma("unroll") for (int mi = 0; mi < 8; ++mi) {
#define EPIV8_INNER                                                             \
  _Pragma("unroll") for (int ni = 0; ni < 4; ++ni) {                            \
    const int lrow = wm * 128 + mi * 16 + (lz & 15);                            \
    const int lcol0 = wn * 64 + ni * 16 + (lz >> 4) * 4;

__device__ void transpose_cvt(const float* __restrict__ src, int K, int N, u16* __restrict__ dst, int Npad,
                              int mode, char* smem, const int nb) {
  float* tile = (float*)smem;
  const int tid = threadIdx.x;
  const int nkt = K / 64, nnt = Npad / 64;
  for (int u = blockIdx.x; u < nkt * nnt; u += nb) {
    const int kt = u % nkt, nt = u / nkt;
    const int k0 = kt * 64, n0 = nt * 64;
#pragma unroll
    for (int i = 0; i < 4; ++i) {
      const int e = tid + i * 256;
      const int kk = e >> 4, nq = (e & 15) * 4;
      const int n = n0 + nq;
      int sc = n;
      if (mode == 1) sc = n < 5120 ? n : (n < 9216 ? n + 16 : (n < 9232 ? n - 9216 + 5120 : -1));
      float4 v = float4{0.f, 0.f, 0.f, 0.f};
      if (sc >= 0) v = *(const float4*)(src + (size_t)(k0 + kk) * N + sc);
      tile[kk * 65 + nq + 0] = v.x; tile[kk * 65 + nq + 1] = v.y; tile[kk * 65 + nq + 2] = v.z; tile[kk * 65 + nq + 3] = v.w;
    }
    __syncthreads();
#pragma unroll
    for (int i = 0; i < 8; ++i) {
      const int e = tid + i * 256;
      const int nn = e >> 5, kp = (e & 31) * 2;
      const unsigned w = pack2(tile[kp * 65 + nn], tile[(kp + 1) * 65 + nn]);
      *(unsigned*)(dst + (size_t)(n0 + nn) * K + k0 + kp) = w;
    }
    __syncthreads();
  }
}

__device__ void cvt_straight(const float* __restrict__ src, u16* __restrict__ dst, size_t n, const int nb) {
  const size_t n4 = n >> 2;
  for (size_t i = (size_t)blockIdx.x * 256 + threadIdx.x; i < n4; i += (size_t)nb * 256) {
    float4 v = ((const float4*)src)[i];
    uint2 o;
    o.x = pack2(v.x, v.y);
    o.y = pack2(v.z, v.w);
    ((uint2*)dst)[i] = o;
  }
}

__device__ void cvt_fp8(const float* __restrict__ src, unsigned char* __restrict__ dst, size_t n, float scale, const int nb) {
  const size_t n8 = n >> 3;
  for (size_t i = (size_t)blockIdx.x * 256 + threadIdx.x; i < n8; i += (size_t)nb * 256) {
    float4 a = ((const float4*)src)[2 * i], b = ((const float4*)src)[2 * i + 1];
    int w0 = 0, w1 = 0;
    w0 = __builtin_amdgcn_cvt_pk_fp8_f32(a.x * scale, a.y * scale, w0, false);
    w0 = __builtin_amdgcn_cvt_pk_fp8_f32(a.z * scale, a.w * scale, w0, true);
    w1 = __builtin_amdgcn_cvt_pk_fp8_f32(b.x * scale, b.y * scale, w1, false);
    w1 = __builtin_amdgcn_cvt_pk_fp8_f32(b.z * scale, b.w * scale, w1, true);
    uint2 o;
    o.x = (unsigned)w0;
    o.y = (unsigned)w1;
    ((uint2*)dst)[i] = o;
  }
}

__device__ __forceinline__ void cvt_fp8_chunk(const float* __restrict__ src, unsigned char* __restrict__ dst, float scale) {
#pragma unroll 2
  for (int it = 0; it < 32; ++it) {
    const size_t i = (size_t)it * 256 + threadIdx.x;
    float4 a = ((const float4*)src)[2 * i], b = ((const float4*)src)[2 * i + 1];
    int w0 = 0, w1 = 0;
    w0 = __builtin_amdgcn_cvt_pk_fp8_f32(a.x * scale, a.y * scale, w0, false);
    w0 = __builtin_amdgcn_cvt_pk_fp8_f32(a.z * scale, a.w * scale, w0, true);
    w1 = __builtin_amdgcn_cvt_pk_fp8_f32(b.x * scale, b.y * scale, w1, false);
    w1 = __builtin_amdgcn_cvt_pk_fp8_f32(b.z * scale, b.w * scale, w1, true);
    uint2 o;
    o.x = (unsigned)w0;
    o.y = (unsigned)w1;
    ((uint2*)dst)[i] = o;
  }
}

__device__ void phase0(const Params& P, char* smem) {
  char* ws = P.ws;
  transpose_cvt(P.w_in, 2048, 9232, (u16*)(ws + OFF_WIN), NWIN, 1, smem, P.nblk);
  transpose_cvt(P.w_glu, 1024, 1024, (u16*)(ws + OFF_WGLU), 1024, 0, smem, P.nblk);
  transpose_cvt(P.w_up_ssm, 1024, 2048, (u16*)(ws + OFF_WUPS), 2048, 0, smem, P.nblk);
  transpose_cvt(P.w_up_ml, 1024, 2048, (u16*)(ws + OFF_WUPM), 2048, 0, smem, P.nblk);
  transpose_cvt(P.w_out, 2048, 2048, (u16*)(ws + OFF_WOUT), 2048, 0, smem, P.nblk);
  transpose_cvt(P.peer_wq, 2048, 2048, (u16*)(ws + OFF_WQ), 2048, 0, smem, P.nblk);
  transpose_cvt(P.ple_wg, 2048, 2048, (u16*)(ws + OFF_WPG), 2048, 0, smem, P.nblk);
  transpose_cvt(P.ple_wp, 256, 2048, (u16*)(ws + OFF_WPP), 2048, 0, smem, P.nblk);
  cvt_straight(P.peer_keys, (u16*)(ws + OFF_KEYS), (size_t)8 * 2 * 128 * 128, P.nblk);
  cvt_straight(P.x, (u16*)(ws + OFF_A0), (size_t)T_TOK * 2048, P.nblk);
  cvt_straight(P.p, (u16*)(ws + OFF_PB), (size_t)T_TOK * 256, P.nblk);
  {
    float* sp = (float*)(ws + OFF_SP);
    const int gt = blockIdx.x * 256 + threadIdx.x, gs = P.nblk * 256;
    for (int i = gt; i < 8; i += gs) { sp[SP_BIG + i] = P.b_ig[i]; sp[SP_BFG + i] = P.b_fg[i]; }
    for (int i = gt; i < 8192; i += gs) sp[SP_CONV + i] = P.conv_qk[i];
    for (int i = gt; i < 1024; i += gs) { sp[SP_MHW + i] = P.mh_norm_w[i]; sp[SP_SSMD + i] = P.ssm_d[i]; sp[SP_BGLU + i] = P.b_glu[i]; }
    for (int i = gt; i < 65536; i += gs) { sp[SP_CRE + i] = P.c_re[i]; sp[SP_CIM + i] = P.c_im[i]; }
    for (int i = gt; i < 2048; i += gs) { sp[SP_LN1G + i] = P.ln1_g[i]; sp[SP_LN1B + i] = P.ln1_b[i]; sp[SP_LN2G + i] = P.ln2_g[i]; sp[SP_LN2B + i] = P.ln2_b[i]; }
  }
  if (blockIdx.x == 0 && threadIdx.x == 0) {
    const float** pt = (const float**)(ws + OFF_TCTR + 64);
    pt[0] = P.peer_u;
    pt[1] = P.peer_v;
  }
  float* lam_r = (float*)(ws + OFF_S5P);
  float* lam_i = lam_r + 4096;
  float* bbar_r = lam_i + 4096;
  float* bbar_i = bbar_r + 65536;
  for (int i = blockIdx.x * 256 + threadIdx.x; i < 4096; i += P.nblk * 256) {
    const int g = i >> 6;
    const double ar = P.a_re[i], ai = P.a_im[i];
    const double dt = (double)expf(P.log_dt[g]);
    const double mag = (double)expf((float)(dt * ar));
    const double ang = dt * ai;
    const double kq = rint(ang * 0.15915494309189535);
    const float red = (float)(ang - kq * 6.283185307179586);
    const double lr = mag * (double)cosf(red), li = mag * (double)sinf(red);
    const double den = ar * ar + ai * ai;
    const double zr = ((lr - 1.0) * ar + li * ai) / den;
    const double zi = (li * ar - (lr - 1.0) * ai) / den;
    lam_r[i] = (float)lr;
    lam_i[i] = (float)li;
#pragma unroll 4
    for (int c = 0; c < 16; ++c) {
      const double br = P.b_re[i * 16 + c], bi = P.b_im[i * 16 + c];
      bbar_r[i * 16 + c] = (float)(zr * br - zi * bi);
      bbar_i[i * 16 + c] = (float)(zr * bi + zi * br);
    }
  }
}

#define SPF ((const float*)(P.ws + OFF_SP))
template <int DEPTH>
__device__ __forceinline__ void p1_tile(const Params& P, char* smem, const int mt, const int nt) {
  char* ws = P.ws;
  const u16* xb = (const u16*)(ws + OFF_A0);
  const u16* wt = (const u16*)(ws + OFF_WIN);
  float* us = (float*)(ws + OFF_A1);
  u16* qkvo = (u16*)(ws + OFF_A2);
  u16* gates = (u16*)(ws + OFF_A3);
  float* ifg = (float*)(ws + OFF_IF);
  const int tid = threadIdx.x, lane = tid & 63, wave = tid >> 6, wm = wave >> 1, wn = wave & 1;
  {

    const int m0 = mt * 128, n0 = nt * 128;
    f32x4 acc[4][4];
    zero_acc(acc);
    gemm_mainloop<DEPTH>(acc, xb + (size_t)m0 * 2048, 2048, wt + (size_t)n0 * 2048, 2048, 2048, smem);
    if (n0 < 1024) {
      EPIV_BEGIN EPIV_INNER
        *(f32x4*)(us + (size_t)(m0 + lrow) * 1024 + n0 + lcol0) = acc[mi][ni];
      EPIV_INNER_END EPIV_END
    } else if (n0 < 4096) {
      EPIV_BEGIN EPIV_INNER
        *(uint2*)(qkvo + (size_t)(m0 + lrow) * 4096 + (n0 - 1024) + lcol0) = pack4(acc[mi][ni]);
      EPIV_INNER_END EPIV_END
    } else if (n0 < 5120) {
      EPIV_BEGIN EPIV_INNER
        *(uint2*)(qkvo + (size_t)(m0 + lrow) * 4096 + (n0 - 1024) + lcol0) = pack4(sigmoid4(acc[mi][ni]));
      EPIV_INNER_END EPIV_END
    } else if (n0 < 9216) {
      EPIV_BEGIN EPIV_INNER
        *(uint2*)(gates + (size_t)(m0 + lrow) * 4096 + (n0 - 5120) + lcol0) = pack4(sigmoid4(acc[mi][ni]));
      EPIV_INNER_END EPIV_END
    } else {
      EPIV_BEGIN EPIV_INNER
        if (lcol0 < 16) {
          f32x4 v = acc[mi][ni];
#pragma unroll
          for (int j = 0; j < 4; ++j) v[j] += (lcol0 + j) < 8 ? (SPF + SP_BIG)[lcol0 + j] : (SPF + SP_BFG)[lcol0 + j - 8];
          *(f32x4*)(ifg + (size_t)(m0 + lrow) * 16 + lcol0) = v;
        }
      EPIV_INNER_END EPIV_END
    }
  }
}

__device__ void phase1(const Params& P, char* smem) {
  for (int tile = blockIdx.x; tile < 64 * 40; tile += P.nblk) {
    const int mt = tile & 63, i = tile >> 6;
    p1_tile<2>(P, smem, mt, i < 39 ? i : 72);
  }
}

__device__ void phase1c(const Params& P, char* smem) {
  char* ws = P.ws;
  const u16* qkvo = (const u16*)(ws + OFF_A2);
  u16* qkc = (u16*)(ws + OFF_QKC);
  const int gt = blockIdx.x * 256 + threadIdx.x, gs = P.nblk * 256;
  for (int item = gt; item < (T_TOK / 8) * 256; item += gs) {
    const int cg = item & 255, tb = item >> 8;
    const int col = cg * 8;
    const int tok0 = tb * 8, sp0 = tok0 & 2047;
    float cw[4][8];
#pragma unroll
    for (int j = 0; j < 4; ++j)
#pragma unroll
      for (int i = 0; i < 8; ++i) cw[j][i] = (SPF + SP_CONV)[j * 2048 + col + i];
    const float kscale = col >= 1024 ? 0.08838834764831845f : 1.f;
    const u16* base = qkvo + (size_t)(tok0 - sp0) * 4096 + col;
    float x0[8], x1[8], x2[8], x3[8];
    auto ldrow = [&](int sp, float (&dst)[8]) {
      if (sp >= 0) {
        uint4 r = *(const uint4*)(base + (size_t)sp * 4096);
        dst[0] = bflo(r.x); dst[1] = bfhi(r.x); dst[2] = bflo(r.y); dst[3] = bfhi(r.y);
        dst[4] = bflo(r.z); dst[5] = bfhi(r.z); dst[6] = bflo(r.w); dst[7] = bfhi(r.w);
      } else {
#pragma unroll
        for (int i = 0; i < 8; ++i) dst[i] = 0.f;
      }
    };
    ldrow(sp0 - 3, x0);
    ldrow(sp0 - 2, x1);
    ldrow(sp0 - 1, x2);
#pragma unroll
    for (int r = 0; r < 8; ++r) {
      ldrow(sp0 + r, x3);
      float o[8];
#pragma unroll
      for (int i = 0; i < 8; ++i) {
        float c = cw[0][i] * x0[i] + cw[1][i] * x1[i] + cw[2][i] * x2[i] + cw[3][i] * x3[i];
        o[i] = c * sigmoidf_(c) * kscale;
      }
      uint4 w;
      w.x = pack2(o[0], o[1]); w.y = pack2(o[2], o[3]); w.z = pack2(o[4], o[5]); w.w = pack2(o[6], o[7]);
      *(uint4*)(qkc + (size_t)(tok0 + r) * 2048 + col) = w;
#pragma unroll
      for (int i = 0; i < 8; ++i) { x0[i] = x1[i]; x1[i] = x2[i]; x2[i] = x3[i]; }
    }
  }
}

__device__ void s5_unit(const Params& P, int unit, char* smem) {
  char* ws = P.ws;
  const int tid = threadIdx.x, lane = tid & 63, wave = tid >> 6;
  const int b = unit >> 4, g = (unit & 15) * 4 + wave;
  float* BU = (float*)(smem + wave * 13568);
  u16* Sb = (u16*)(smem + wave * 13568 + 8192);
  const float* us = (const float*)(ws + OFF_A1);
  u16* yg = (u16*)(ws + OFF_A4);
  const float* lam_r = (const float*)(ws + OFF_S5P);
  const float* lam_i = lam_r + 4096;
  const float* bbar_r = lam_i + 4096;
  const float* bbar_i = bbar_r + 65536;
  const int l15 = lane & 15, lq = lane >> 4;
  bf16x8 bfr[8];
#pragma unroll
  for (int nt = 0; nt < 8; ++nt) {
    const int n = nt * 16 + l15;
    bf16x8 v = {0, 0, 0, 0, 0, 0, 0, 0};
    if (lq < 2) {
      const float* src = (n < 64) ? (bbar_r + ((size_t)(g * 64 + n) * 16 + lq * 8))
                                  : (bbar_i + ((size_t)(g * 64 + n - 64) * 16 + lq * 8));
#pragma unroll
      for (int jj = 0; jj < 8; ++jj) v[jj] = (short)f2bf(src[jj]);
    }
    bfr[nt] = v;
  }
  const float dsk = (SPF + SP_SSMD)[g * 16 + l15];
  bf16x8 cfr[5];
#pragma unroll
  for (int ks = 0; ks < 5; ++ks) {
    const int nb = ks * 32 + lq * 8;
    bf16x8 v;
#pragma unroll
    for (int jj = 0; jj < 8; ++jj) {
      const int n = nb + jj;
      float val;
      if (n < 64) val = (SPF + SP_CRE)[(size_t)(g * 16 + l15) * 64 + n];
      else if (n < 128) val = -(SPF + SP_CIM)[(size_t)(g * 16 + l15) * 64 + (n - 64)];
      else val = (n - 128 == l15) ? dsk : 0.f;
      v[jj] = (short)f2bf(val);
    }
    cfr[ks] = v;
  }
  const float lr = lam_r[g * 64 + lane], li = lam_i[g * 64 + lane];
  float sr = 0.f, si = 0.f;
  float4 pv0 = float4{0.f, 0.f, 0.f, 0.f}, pv1 = pv0;
  if (lq < 2) {
    const float* src = us + (size_t)(b * 2048 + l15) * 1024 + g * 16 + lq * 8;
    pv0 = *(const float4*)src; pv1 = *(const float4*)(src + 4);
  }
  for (int sc = 0; sc < 128; ++sc) {
    const int t0 = b * 2048 + sc * 16;
    {
      bf16x8 af;
      af[0] = (short)f2bf(pv0.x); af[1] = (short)f2bf(pv0.y); af[2] = (short)f2bf(pv0.z); af[3] = (short)f2bf(pv0.w);
      af[4] = (short)f2bf(pv1.x); af[5] = (short)f2bf(pv1.y); af[6] = (short)f2bf(pv1.z); af[7] = (short)f2bf(pv1.w);
      if (lq < 2 && sc + 1 < 128) {
        const float* src = us + (size_t)(t0 + 16 + l15) * 1024 + g * 16 + lq * 8;
        pv0 = *(const float4*)src; pv1 = *(const float4*)(src + 4);
      }
      *(bf16x8*)(Sb + l15 * 168 + 128 + lq * 8) = af;
#pragma unroll
      for (int nt = 0; nt < 8; ++nt) {
        f32x4 a = mfma16(af, bfr[nt], f32x4{0.f, 0.f, 0.f, 0.f});
#pragma unroll
        for (int jj = 0; jj < 4; ++jj) BU[(lq * 4 + jj) * 128 + nt * 16 + l15] = a[jj];
      }
    }
    __builtin_amdgcn_fence(__ATOMIC_RELEASE, "wavefront");
    __builtin_amdgcn_wave_barrier();
    __builtin_amdgcn_fence(__ATOMIC_ACQUIRE, "wavefront");
    {
      float bre[16], bim[16];
#pragma unroll
      for (int t = 0; t < 16; ++t) { bre[t] = BU[t * 128 + lane]; bim[t] = BU[t * 128 + 64 + lane]; }
#pragma unroll
      for (int t = 0; t < 16; ++t) {
        const float nsr = lr * sr - li * si + bre[t];
        const float nsi = lr * si + li * sr + bim[t];
        sr = nsr; si = nsi;
        bre[t] = sr; bim[t] = si;
      }
#pragma unroll
      for (int t = 0; t < 16; ++t) {
        Sb[t * 168 + lane] = f2bf(bre[t]);
        Sb[t * 168 + 64 + lane] = f2bf(bim[t]);
      }
    }
    __builtin_amdgcn_fence(__ATOMIC_RELEASE, "wavefront");
    __builtin_amdgcn_wave_barrier();
    __builtin_amdgcn_fence(__ATOMIC_ACQUIRE, "wavefront");
    {
      f32x4 a = {0.f, 0.f, 0.f, 0.f};
#pragma unroll
      for (int ks = 0; ks < 5; ++ks) {
        bf16x8 af = *(const bf16x8*)(Sb + l15 * 168 + ks * 32 + lq * 8);
        a = mfma16(af, cfr[ks], a);
      }
#pragma unroll
      for (int jj = 0; jj < 4; ++jj) {
        const size_t t = (size_t)t0 + lq * 4 + jj;
        yg[t * 1024 + g * 16 + l15] = f2bf(gelu_tanh(a[jj]));
      }
    }
    __builtin_amdgcn_fence(__ATOMIC_RELEASE, "wavefront");
    __builtin_amdgcn_wave_barrier();
    __builtin_amdgcn_fence(__ATOMIC_ACQUIRE, "wavefront");
  }
  __syncthreads();
}

__device__ __forceinline__ void lds_barrier() { asm volatile("s_waitcnt lgkmcnt(0)\n\ts_barrier" ::: "memory"); }

__device__ void mlstm_unit(const Params& P, int unit, char* smem) {
  char* ws = P.ws;
  const int b = unit >> 6, h = (unit >> 3) & 7, sl = unit & 7;
  u16* qs = (u16*)smem;
  u16* ks_ = qs + 64 * 136;
  u16* vT = ks_ + 64 * 136;
  u16* wvT = vT + 16 * 72;
  u16* scs = wvT + 16 * 72;
  u16* CT = scs + 64 * 72;
  float* fl = (float*)(CT + 16 * 136);
  float* es = fl;
  float* rts = fl + 64;
  float* isc = fl + 128;
  float* emr = fl + 192;
  float* wts = fl + 256;
  float* nst = fl + 320;
  float* qn = fl + 448;
  float* scal = fl + 512;
  u16* wtsb = (u16*)(fl + 520);
  u16* nT = wtsb + 64;
  const u16* qkvo = (const u16*)(ws + OFF_A2);
  const float* ifg = (const float*)(ws + OFF_IF);
  float* hm = (float*)(ws + OFF_A4 + A4_HM);
  const int tid = threadIdx.x, lane = tid & 63, wave = tid >> 6;
  const int l15 = lane & 15, lq = lane >> 4;
  const u16* qkc = (const u16*)(ws + OFF_QKC);
  const int vs = tid >> 2, vdq = (tid & 3) * 4;
  for (int i = tid; i < 16 * 136; i += 256) CT[i] = 0;
  if (tid < 128) { nst[tid] = 0.f; nT[tid] = 0; }
  f32x4 nacc[2];
  nacc[0] = f32x4{0.f, 0.f, 0.f, 0.f};
  nacc[1] = f32x4{0.f, 0.f, 0.f, 0.f};
  f32x4 stacc[2];
  stacc[0] = f32x4{0.f, 0.f, 0.f, 0.f};
  stacc[1] = f32x4{0.f, 0.f, 0.f, 0.f};
  float m_st = 0.f;
  uint4 pq0, pq1, pq2, pq3, pq4, pq5, pq6, pq7;
  uint2 pvv;
  float pig = 0.f, pfp = 0.f;
#define ML_PIECE_SRC(i, T0) (qkc + (size_t)((T0) + (((tid + (i) * 256) >> 4) & 63)) * 2048 + ((tid + (i) * 256) >> 10) * 1024 + h * 128 + ((tid + (i) * 256) & 15) * 8)
#define ML_PIECE_DST(i) ((((tid + (i) * 256) >> 10) ? ks_ : qs) + (((tid + (i) * 256) >> 4) & 63) * 136 + ((tid + (i) * 256) & 15) * 8)
#define ML_PREFETCH(T0) {                                                                          \
    pq0 = *(const uint4*)ML_PIECE_SRC(0, T0); pq1 = *(const uint4*)ML_PIECE_SRC(1, T0);            \
    pq2 = *(const uint4*)ML_PIECE_SRC(2, T0); pq3 = *(const uint4*)ML_PIECE_SRC(3, T0);            \
    pq4 = *(const uint4*)ML_PIECE_SRC(4, T0); pq5 = *(const uint4*)ML_PIECE_SRC(5, T0);            \
    pq6 = *(const uint4*)ML_PIECE_SRC(6, T0); pq7 = *(const uint4*)ML_PIECE_SRC(7, T0);            \
    pvv = *(const uint2*)(qkvo + (size_t)((T0) + vs) * 4096 + 2048 + h * 128 + sl * 16 + vdq);     \
    if (wave == 0) { pig = ifg[(size_t)((T0) + lane) * 16 + h]; pfp = ifg[(size_t)((T0) + lane) * 16 + 8 + h]; } }
  ML_PREFETCH(b * 2048)
  __syncthreads();
  for (int chunk = 0; chunk < 32; ++chunk) {
    const int t0 = b * 2048 + chunk * 64;
    *(uint4*)ML_PIECE_DST(0) = pq0; *(uint4*)ML_PIECE_DST(1) = pq1; *(uint4*)ML_PIECE_DST(2) = pq2; *(uint4*)ML_PIECE_DST(3) = pq3;
    *(uint4*)ML_PIECE_DST(4) = pq4; *(uint4*)ML_PIECE_DST(5) = pq5; *(uint4*)ML_PIECE_DST(6) = pq6; *(uint4*)ML_PIECE_DST(7) = pq7;
    float vreg[4];
    {
      vreg[0] = bflo(pvv.x); vreg[1] = bfhi(pvv.x); vreg[2] = bflo(pvv.y); vreg[3] = bfhi(pvv.y);
#pragma unroll
      for (int i = 0; i < 4; ++i) vT[(vdq + i) * 72 + vs] = f2bf(vreg[i]);
    }
    const float ig_c = pig, fp_c = pfp;
    if (chunk + 1 < 32) ML_PREFETCH(t0 + 64)
    if (wave == 0) {
      const float ig = ig_c;
      const float fp = fp_c;
      const float logf = fminf(fp, 0.f) - log1pf(__expf(-fabsf(fp)));
      const float bc = wave_scan_sum(logf);
      const float gtot = rdl(bc, 63);
      const float e = ig - bc;
      const float pm = wave_scan_max(e);
      const float mloc = gtot + rdl(pm, 63);
      const float m_prev = m_st;
      const float m_new = fmaxf(gtot + m_prev, mloc);
      const float a = __expf(gtot + m_prev - m_new);
      const float wl = gtot + e;
      const float rt = -fmaxf(m_prev, pm);
      es[lane] = e;
      rts[lane] = rt;
      isc[lane] = __expf(m_prev + rt);
      emr[lane] = __expf(rt - bc);
      wts[lane] = __expf(wl - m_new);
      wtsb[lane] = f2bf(__expf(wl - m_new));
      if (lane == 0) scal[0] = a;
      m_st = m_new;
    }
    lds_barrier();
#pragma unroll
    for (int i = 0; i < 4; ++i) wvT[(vdq + i) * 72 + vs] = f2bf(wts[vs] * vreg[i]);
    bf16x8 afr[4];
    f32x4 sacc[4];
#pragma unroll
    for (int ni = 0; ni < 4; ++ni) sacc[ni] = f32x4{0.f, 0.f, 0.f, 0.f};
#pragma unroll
    for (int kk = 0; kk < 4; ++kk) {
      afr[kk] = *(const bf16x8*)(qs + (wave * 16 + l15) * 136 + kk * 32 + lq * 8);
#pragma unroll
      for (int ni = 0; ni < 4; ++ni) {
        bf16x8 bb = *(const bf16x8*)(ks_ + (ni * 16 + l15) * 136 + kk * 32 + lq * 8);
        sacc[ni] = mfma16(afr[kk], bb, sacc[ni]);
      }
    }
    float rowsum[4];
#pragma unroll
    for (int jj = 0; jj < 4; ++jj) {
      const int t = wave * 16 + lq * 4 + jj;
      const float rt_t = rts[t];
      float rs = 0.f;
#pragma unroll
      for (int ni = 0; ni < 4; ++ni) {
        const int s = ni * 16 + l15;
        float val = (s <= t) ? sacc[ni][jj] * __expf(rt_t + es[s]) : 0.f;
        rs += val;
        scs[t * 72 + s] = f2bf(val);
      }
      rowsum[jj] = row_sum(rs);
    }
    f32x4 cacc = {0.f, 0.f, 0.f, 0.f};
#pragma unroll
    for (int kk = 0; kk < 4; ++kk) {
      bf16x8 bb = *(const bf16x8*)(CT + l15 * 136 + kk * 32 + lq * 8);
      cacc = mfma16(afr[kk], bb, cacc);
    }
    {
      f32x4 qnacc = {0.f, 0.f, 0.f, 0.f};
#pragma unroll
      for (int kk = 0; kk < 4; ++kk) {
        bf16x8 bn = {0, 0, 0, 0, 0, 0, 0, 0};
        if (l15 == 0) bn = *(const bf16x8*)(nT + kk * 32 + lq * 8);
        qnacc = mfma16(afr[kk], bn, qnacc);
      }
      if (l15 == 0) {
#pragma unroll
        for (int jj = 0; jj < 4; ++jj) qn[wave * 16 + lq * 4 + jj] = qnacc[jj];
      }
    }
    lds_barrier();
    {
      f32x4 nacc = {0.f, 0.f, 0.f, 0.f};
#pragma unroll
      for (int kk = 0; kk < 2; ++kk) {
        bf16x8 aa = *(const bf16x8*)(scs + (wave * 16 + l15) * 72 + kk * 32 + lq * 8);
        bf16x8 bb = *(const bf16x8*)(vT + l15 * 72 + kk * 32 + lq * 8);
        nacc = mfma16(aa, bb, nacc);
      }
#pragma unroll
      for (int jj = 0; jj < 4; ++jj) {
        const int t = wave * 16 + lq * 4 + jj;
        const float is = isc[t];
        const float num = nacc[jj] + is * cacc[jj];
        const float den = rowsum[jj] + is * qn[t];
        hm[(size_t)(t0 + t) * 1024 + h * 128 + sl * 16 + l15] = num / fmaxf(fabsf(den), emr[t]);
      }
    }
    {
      const float a = scal[0];
#pragma unroll
      for (int i = 0; i < 2; ++i) {
        const int sub = wave * 2 + i;
        f32x4 st = stacc[i];
        st[0] *= a; st[1] *= a; st[2] *= a; st[3] *= a;
        f32x4 na = nacc[i];
        na[0] *= a; na[1] *= a; na[2] *= a; na[3] *= a;
#pragma unroll
        for (int kk = 0; kk < 2; ++kk) {
          bf16x8 aa = *(const bf16x8*)(wvT + l15 * 72 + kk * 32 + lq * 8);
          bf16x8 bb;
#pragma unroll
          for (int jj = 0; jj < 8; ++jj) bb[jj] = (short)ks_[(kk * 32 + lq * 8 + jj) * 136 + sub * 16 + l15];
          st = mfma16(aa, bb, st);
          bf16x8 aw = {0, 0, 0, 0, 0, 0, 0, 0};
          if (l15 == 0) aw = *(const bf16x8*)(wtsb + kk * 32 + lq * 8);
          na = mfma16(aw, bb, na);
        }
        stacc[i] = st;
        nacc[i] = na;
        if (lq == 0) nT[sub * 16 + l15] = f2bf(na[0]);
#pragma unroll
        for (int jj = 0; jj < 4; ++jj) CT[(lq * 4 + jj) * 136 + sub * 16 + l15] = f2bf(st[jj]);
      }
    }
    lds_barrier();
  }
}

__device__ void phase2(const Params& P, char* smem) {
  for (int u = blockIdx.x; u < 320; u += P.nblk) {
    if (u < 64) s5_unit(P, u, smem);
    else mlstm_unit(P, u - 64, smem);
  }
  unsigned* ctr = (unsigned*)(P.ws + OFF_TCTR);
  volatile int* s_tile = (volatile int*)(smem + 73728);
  for (;;) {
    __syncthreads();
    if (threadIdx.x == 0) *s_tile = (int)atomicAdd(ctr, 1u);
    __syncthreads();
    const int it = *s_tile;
    if (it >= 3072 + 64) break;
    const int q = it / 3, r = it - q * 3;
    if (it >= 3072) {
      p1_tile<1>(P, smem, it - 3072, 39);
    } else if (r < 2) {
      const int g = 2 * q + r;
      p1_tile<1>(P, smem, g & 63, 40 + (g >> 6));
    } else {
      const size_t off = (size_t)(q & 511) * 65536;
      const float* const* pt = (const float* const*)(P.ws + OFF_TCTR + 64);
      if (q < 512) cvt_fp8_chunk(pt[0] + off, (unsigned char*)(P.ws + OFF_UB) + off, U_SCALE);
      else cvt_fp8_chunk(pt[1] + off, (unsigned char*)(P.ws + OFF_VB) + off, V_SCALE);
    }
  }
}

__device__ void phase3(const Params& P, char* smem) {
  char* ws = P.ws;
  const u16* yg = (const u16*)(ws + OFF_A4);
  const u16* wt = (const u16*)(ws + OFF_WGLU);
  u16* ya = (u16*)(ws + OFF_A1);
  u16* yb = ya + (size_t)T_TOK * 1024;
  const float* hm = (const float*)(ws + OFF_A4 + A4_HM);
  const u16* qkvo = (const u16*)(ws + OFF_A2);
  const int tid = threadIdx.x, lane = tid & 63, wave = tid >> 6, wm = wave >> 1, wn = wave & 1;
  for (int tile = blockIdx.x; tile < 64 * 8; tile += P.nblk) {
    const int mt = tile & 63, nt = tile >> 6;
    const int m0 = mt * 128, n0 = nt * 128;
    f32x4 acc[4][4];
    zero_acc(acc);
    gemm_mainloop(acc, yg + (size_t)m0 * 1024, 1024, wt + (size_t)n0 * 1024, 1024, 1024, smem);
    EPIV_BEGIN
      uint2 yv[4];
      EPIV_INNER
        yv[ni] = *(const uint2*)(yg + (size_t)(m0 + lrow) * 1024 + n0 + lcol0);
      EPIV_INNER_END
      EPIV_MID
      EPIV_INNER
        const f32x4 y = unpack4(yv[ni]);
        const f32x4 bg = *(const f32x4*)((SPF + SP_BGLU) + n0 + lcol0);
        const f32x4 g = sigmoid4(acc[mi][ni] + bg);
        *(uint2*)(ya + (size_t)(m0 + lrow) * 1024 + n0 + lcol0) = pack4(y * g);
      EPIV_INNER_END
    EPIV_END
  }
  for (int t = blockIdx.x * 4 + wave; t < T_TOK; t += P.nblk * 4) {
    const int c0 = (lane >> 3) * 128 + (lane & 7) * 16;
    float v[16], ov[16];
#pragma unroll
    for (int k = 0; k < 4; ++k) {
      const f32x4 a = *(const f32x4*)(hm + (size_t)t * 1024 + c0 + k * 4);
      v[k * 4 + 0] = a[0]; v[k * 4 + 1] = a[1]; v[k * 4 + 2] = a[2]; v[k * 4 + 3] = a[3];
    }
#pragma unroll
    for (int k = 0; k < 2; ++k) {
      const uint4 o = *(const uint4*)(qkvo + (size_t)t * 4096 + 3072 + c0 + k * 8);
      ov[k * 8 + 0] = bflo(o.x); ov[k * 8 + 1] = bfhi(o.x); ov[k * 8 + 2] = bflo(o.y); ov[k * 8 + 3] = bfhi(o.y);
      ov[k * 8 + 4] = bflo(o.z); ov[k * 8 + 5] = bfhi(o.z); ov[k * 8 + 6] = bflo(o.w); ov[k * 8 + 7] = bfhi(o.w);
    }
    float sm = 0.f;
#pragma unroll
    for (int j = 0; j < 16; ++j) sm += v[j];
    sm += dpp_f<0xB1>(sm); sm += dpp_f<0x4E>(sm); sm += dpp_f<0x141>(sm);
    const float mean = sm * (1.f / 128.f);
    float q = 0.f;
#pragma unroll
    for (int j = 0; j < 16; ++j) { v[j] -= mean; q += v[j] * v[j]; }
    q += dpp_f<0xB1>(q); q += dpp_f<0x4E>(q); q += dpp_f<0x141>(q);
    const float rstd = rsqrtf(q * (1.f / 128.f) + 1e-5f);
    float ob[16];
#pragma unroll
    for (int k = 0; k < 4; ++k) {
      const f32x4 wv = *(const f32x4*)(SPF + SP_MHW + c0 + k * 4);
#pragma unroll
      for (int j = 0; j < 4; ++j) ob[k * 4 + j] = ov[k * 4 + j] * v[k * 4 + j] * rstd * wv[j];
    }
    uint4 w0, w1;
    w0.x = pack2(ob[0], ob[1]); w0.y = pack2(ob[2], ob[3]); w0.z = pack2(ob[4], ob[5]); w0.w = pack2(ob[6], ob[7]);
    w1.x = pack2(ob[8], ob[9]); w1.y = pack2(ob[10], ob[11]); w1.z = pack2(ob[12], ob[13]); w1.w = pack2(ob[14], ob[15]);
    *(uint4*)(yb + (size_t)t * 1024 + c0) = w0;
    *(uint4*)(yb + (size_t)t * 1024 + c0 + 8) = w1;
  }
}

__device__ void phase4b(const Params& P, char* smem) {
  char* ws = P.ws;
  const u16* ya = (const u16*)(ws + OFF_A1);
  const u16* yb = ya + (size_t)T_TOK * 1024;
  const u16* w1 = (const u16*)(ws + OFF_WUPS);
  const u16* w2 = (const u16*)(ws + OFF_WUPM);
  const u16* gates = (const u16*)(ws + OFF_A3);
  float* tmpg = (float*)(ws + OFF_A4);
  u16* merged = (u16*)(ws + OFF_A0);
  const int tid = threadIdx.x, lane = tid & 63, wave = tid >> 6, wm = wave >> 1, wn = wave & 1;
  for (int tile = blockIdx.x; tile < 32 * 16; tile += P.nblk) {
    const int mt = tile & 31, nt = tile >> 5;
    const int m0 = mt * 256, n0 = nt * 128;
    f32x4 acc[8][4];
    zero_acc8(acc);
    gemm_mainloop_big(acc, ya + (size_t)m0 * 1024, 1024, w1 + (size_t)n0 * 1024, 1024, 1024, smem);
    EPIV8_BEGIN
      uint2 gv[4];
      EPIV8_INNER
        gv[ni] = *(const uint2*)(gates + (size_t)(m0 + lrow) * 4096 + n0 + lcol0);
      EPIV_INNER_END
      EPIV_MID
      EPIV8_INNER
        *(f32x4*)(tmpg + (size_t)(m0 + lrow) * 2048 + n0 + lcol0) = unpack4(gv[ni]) * acc[mi][ni];
      EPIV_INNER_END
    EPIV_END
    zero_acc8(acc);
    gemm_mainloop_big(acc, yb + (size_t)m0 * 1024, 1024, w2 + (size_t)n0 * 1024, 1024, 1024, smem);
    EPIV8_BEGIN
      uint2 gv[4];
      f32x4 tv[4];
      EPIV8_INNER
        gv[ni] = *(const uint2*)(gates + (size_t)(m0 + lrow) * 4096 + 2048 + n0 + lcol0);
        tv[ni] = *(const f32x4*)(tmpg + (size_t)(m0 + lrow) * 2048 + n0 + lcol0);
      EPIV_INNER_END
      EPIV_MID
      EPIV8_INNER
        *(uint2*)(merged + (size_t)(m0 + lrow) * 2048 + n0 + lcol0) = pack4(tv[ni] + unpack4(gv[ni]) * acc[mi][ni]);
      EPIV_INNER_END
    EPIV_END
  }
}

__device__ void phase5(const Params& P, char* smem) {
  char* ws = P.ws;
  const u16* merged = (const u16*)(ws + OFF_A0);
  const u16* wt = (const u16*)(ws + OFF_WOUT);
  float* r1 = (float*)(ws + OFF_A2);
  const int tid = threadIdx.x, lane = tid & 63, wave = tid >> 6, wm = wave >> 1, wn = wave & 1;
  for (int tile = blockIdx.x; tile < 32 * 16; tile += P.nblk) {
    const int mt = tile & 31, nt = tile >> 5;
    const int m0 = mt * 256, n0 = nt * 128;
    f32x4 acc[8][4];
    zero_acc8(acc);
    gemm_mainloop_big(acc, merged + (size_t)m0 * 2048, 2048, wt + (size_t)n0 * 2048, 2048, 2048, smem);
    EPIV8_BEGIN
      f32x4 xv[4];
      EPIV8_INNER
        xv[ni] = *(const f32x4*)(P.x + (size_t)(m0 + lrow) * 2048 + n0 + lcol0);
      EPIV_INNER_END
      EPIV_MID
      EPIV8_INNER
        *(f32x4*)(r1 + (size_t)(m0 + lrow) * 2048 + n0 + lcol0) = xv[ni] * DN_ALPHA + acc[mi][ni];
      EPIV_INNER_END
    EPIV_END
  }
}

__device__ void phase6(const Params& P, char* smem) {
  char* ws = P.ws;
  float* r1 = (float*)(ws + OFF_A2);
  u16* h1b = (u16*)(ws + OFF_A0);
  const int tid = threadIdx.x, lane = tid & 63, wave = tid >> 6;
  for (int r = blockIdx.x * 4 + wave; r < T_TOK; r += P.nblk * 4) {
    float* row = r1 + (size_t)r * 2048;
    float v[32];
    float s = 0.f;
#pragma unroll
    for (int i = 0; i < 4; ++i) {
      float4 a = *(const float4*)(row + i * 512 + lane * 8);
      float4 c = *(const float4*)(row + i * 512 + lane * 8 + 4);
      v[i * 8 + 0] = a.x; v[i * 8 + 1] = a.y; v[i * 8 + 2] = a.z; v[i * 8 + 3] = a.w;
      v[i * 8 + 4] = c.x; v[i * 8 + 5] = c.y; v[i * 8 + 6] = c.z; v[i * 8 + 7] = c.w;
    }
#pragma unroll
    for (int i = 0; i < 32; ++i) s += v[i];
    const float mean = wave_sum(s) * (1.f / 2048.f);
    float q = 0.f;
#pragma unroll
    for (int i = 0; i < 32; ++i) { v[i] -= mean; q += v[i] * v[i]; }
    const float rstd = rsqrtf(wave_sum(q) * (1.f / 2048.f) + 1e-5f);
#pragma unroll
    for (int i = 0; i < 4; ++i) {
      const int c0 = i * 512 + lane * 8;
      float o[8];
#pragma unroll
      for (int jj = 0; jj < 8; ++jj) o[jj] = v[i * 8 + jj] * rstd * (SPF + SP_LN1G)[c0 + jj] + (SPF + SP_LN1B)[c0 + jj];
      *(float4*)(row + c0) = float4{o[0], o[1], o[2], o[3]};
      *(float4*)(row + c0 + 4) = float4{o[4], o[5], o[6], o[7]};
      uint4 w;
      w.x = pack2(o[0], o[1]); w.y = pack2(o[2], o[3]); w.z = pack2(o[4], o[5]); w.w = pack2(o[6], o[7]);
      *(uint4*)(h1b + (size_t)r * 2048 + c0) = w;
    }
  }
}

__device__ void phase7(const Params& P, char* smem) {
  char* ws = P.ws;
  const u16* h1b = (const u16*)(ws + OFF_A0);
  const u16* wt = (const u16*)(ws + OFF_WQ);
  const u16* keysb = (const u16*)(ws + OFF_KEYS);
  float* tops = (float*)(ws + OFF_A4);
  int* topi = (int*)(ws + OFF_A4 + A4_TOPI);
  const int tid = threadIdx.x, lane = tid & 63, wave = tid >> 6, wm = wave >> 1, wn = wave & 1;
  for (int tile = blockIdx.x; tile < 64 * 16; tile += P.nblk) {
    const int mt = tile & 63, nt = tile >> 6;
    const int m0 = mt * 128, n0 = nt * 128;
    f32x4 acc[4][4];
    zero_acc(acc);
    gemm_mainloop(acc, h1b + (size_t)m0 * 2048, 2048, wt + (size_t)n0 * 2048, 2048, 2048, smem);
    u16* Q = (u16*)smem;
    u16* Kt = Q + 128 * 136;
    EPIV_BEGIN EPIV_INNER
      *(uint2*)(Q + lrow * 136 + lcol0) = pack4(acc[mi][ni]);
    EPIV_INNER_END EPIV_END
    {
      const u16* kb = keysb + (size_t)nt * 128 * 128;
#pragma unroll 4
      for (int i = 0; i < 8; ++i) {
        const int id = tid + i * 256;
        const int row = id >> 4, ch = id & 15;
        *(uint4*)(Kt + row * 136 + ch * 8) = *(const uint4*)(kb + row * 128 + ch * 8);
      }
    }
    __syncthreads();
    zero_acc(acc);
#pragma unroll
    for (int ks = 0; ks < 4; ++ks) {
      bf16x8 af[4], bfr[4];
#pragma unroll
      for (int mi = 0; mi < 4; ++mi)
        af[mi] = *(const bf16x8*)(Q + (wm * 64 + mi * 16 + (lane & 15)) * 136 + ks * 32 + (lane >> 4) * 8);
#pragma unroll
      for (int ni = 0; ni < 4; ++ni)
        bfr[ni] = *(const bf16x8*)(Kt + (wn * 64 + ni * 16 + (lane & 15)) * 136 + ks * 32 + (lane >> 4) * 8);
#pragma unroll
      for (int mi = 0; mi < 4; ++mi)
#pragma unroll
        for (int ni = 0; ni < 4; ++ni) acc[mi][ni] = mfma16(bfr[ni], af[mi], acc[mi][ni]);
    }
    __syncthreads();
    float* Sc = (float*)smem;
    EPIV_BEGIN EPIV_INNER
      *(f32x4*)(Sc + lrow * 132 + lcol0) = acc[mi][ni];
    EPIV_INNER_END EPIV_END
    __syncthreads();
    {
      const int row = tid >> 1, half = tid & 1;
      float* r = Sc + row * 132 + half * 64;
      const size_t ob = ((size_t)(m0 + row) * 16 + nt) * 16;
      for (int k = 0; k < 16; ++k) {
        float best = -3.0e38f;
        int bi = 0;
#pragma unroll 4
        for (int c4 = 0; c4 < 16; ++c4) {
          const f32x4 v4 = *(const f32x4*)(r + c4 * 4);
#pragma unroll
          for (int j = 0; j < 4; ++j)
            if (v4[j] > best) { best = v4[j]; bi = c4 * 4 + j; }
        }
        const float obest = dpp_f<0xB1>(best);
        const int obi = __builtin_amdgcn_update_dpp(0, bi, 0xB1, 0xF, 0xF, false);
        const int mycol = half * 64 + bi, ocol = (half ^ 1) * 64 + obi;
        const bool mine = (best > obest) || (best == obest && mycol < ocol);
        if (half == 0) {
          tops[ob + k] = mine ? best : obest;
          topi[ob + k] = mine ? mycol : ocol;
        }
        if (mine) r[bi] = -3.0e38f;
      }
    }
    __syncthreads();
  }
}

__device__ void phase9(const Params& P, char* smem) {
  char* ws = P.ws;
  const float* h1 = (const float*)(ws + OFF_A2);
  const float* tops = (const float*)(ws + OFF_A4);
  const int* topi = (const int*)(ws + OFF_A4 + A4_TOPI);
  const unsigned char* Ub = (const unsigned char*)(ws + OFF_UB);
  const unsigned char* Vb = (const unsigned char*)(ws + OFF_VB);
  float* h2 = (float*)(ws + OFF_A3);
  u16* h2b = (u16*)(ws + OFF_A4 + A4_H2B);
  const int tid = threadIdx.x, lane = tid & 63, wave = tid >> 6;
  int ca, cb;
  {
    const int l = lane;
    if (l < 16) { ca = 0; cb = l; }
    else if (l < 24) { ca = 1; cb = l - 16; }
    else if (l < 29) { ca = 2; cb = l - 24; }
    else if (l < 33) { ca = 3; cb = l - 29; }
    else if (l < 36) { ca = 4; cb = l - 33; }
    else if (l < 38) { ca = 5; cb = l - 36; }
    else if (l < 40) { ca = 6; cb = l - 38; }
    else if (l < 42) { ca = 7; cb = l - 40; }
    else if (l < 50) { ca = l - 34; cb = 0; }
    else { ca = 0; cb = 0; }
  }
  const bool cvalid = lane < 50;
  f32x4* xs = (f32x4*)(smem + wave * 8192);
  const __amdgpu_buffer_rsrc_t rsU = __builtin_amdgcn_make_buffer_rsrc((void*)Ub, 0, 0x7fffffff, 0x00020000);
  const __amdgpu_buffer_rsrc_t rsV = __builtin_amdgcn_make_buffer_rsrc((void*)Vb, 0, 0x7fffffff, 0x00020000);
  for (int t = blockIdx.x * 4 + wave; t < T_TOK; t += P.nblk * 4) {
    {
      const float* row = h1 + (size_t)t * 2048;
#pragma unroll
      for (int i = 0; i < 2; ++i)
#pragma unroll
        for (int k = 0; k < 4; ++k) xs[(i * 4 + k) * 64 + lane] = *(const f32x4*)(row + i * 1024 + lane * 16 + k * 4);
    }
    float sc0 = 0.f, sc1 = 0.f;
    int id0 = 0, id1 = 0;
#pragma unroll
    for (int hs = 0; hs < 2; ++hs) {
#pragma unroll 1
      for (int hq = 0; hq < 4; ++hq) {
        const int head = hs * 4 + hq;
        const size_t ob = ((size_t)t * 16 + head * 2) * 16;
        float val = -3.0e38f;
        int eid = 0;
        if (cvalid) {
          val = tops[ob + ca] + tops[ob + 16 + cb];
          eid = topi[ob + ca] * 128 + topi[ob + 16 + cb];
        }
#pragma unroll 1
        for (int k = 0; k < 16; ++k) {
          const float m = wave_max(val);
          const unsigned long long mask = __ballot(val == m);
          const int win = __ffsll((long long)mask) - 1;
          const int widx = __builtin_amdgcn_readlane(eid, win);
          if (lane == hq * 16 + k) {
            if (hs == 0) { sc0 = m; id0 = widx; } else { sc1 = m; id1 = widx; }
          }
          if (lane == win) val = -3.0e38f;
        }
      }
    }
    float g0, g1;
    {
      const float mx0 = row_max(sc0), mx1 = row_max(sc1);
      const float e0 = __expf(sc0 - mx0), e1 = __expf(sc1 - mx1);
      const float s0 = row_sum(e0), s1 = row_sum(e1);
      g0 = e0 / s0; g1 = e1 / s1;
    }
    float acc[32];
#pragma unroll
    for (int i = 0; i < 32; ++i) acc[i] = 0.f;
    u32x4v U00, U01, U10, U11, U20, U21, U30, U31, V00, V01, V10, V11, V20, V21, V30, V31;
#define P9_LDU(S, idv) { const int so_ = (idv) * 2048; U##S##0 = __builtin_amdgcn_raw_buffer_load_b128(rsU, lane * 16, so_, 0); U##S##1 = __builtin_amdgcn_raw_buffer_load_b128(rsU, lane * 16 + 1024, so_, 0); }
#define P9_LDV(S, idv) { const int so_ = (idv) * 2048; V##S##0 = __builtin_amdgcn_raw_buffer_load_b128(rsV, lane * 16, so_, 0); V##S##1 = __builtin_amdgcn_raw_buffer_load_b128(rsV, lane * 16 + 1024, so_, 0); }
#define P9_DOT8(W, XB, sacc) {                                                         \
      _Pragma("unroll") for (int k = 0; k < 4; ++k) {                                  \
        const f32x2 lo = __builtin_amdgcn_cvt_pk_f32_fp8((int)(W)[k], false);          \
        const f32x2 hi = __builtin_amdgcn_cvt_pk_f32_fp8((int)(W)[k], true);           \
        const f32x4 xv = xs[((XB) + k) * 64 + lane];                                   \
        sacc##A = f32x2{xv[0], xv[1]} * lo + sacc##A;                                  \
        sacc##B = f32x2{xv[2], xv[3]} * hi + sacc##B;                                  \
      } }
#define P9_AXPY8(W, AB, a_) {                                                          \
      _Pragma("unroll") for (int k = 0; k < 4; ++k) {                                  \
        const f32x2 lo = __builtin_amdgcn_cvt_pk_f32_fp8((int)(W)[k], false);          \
        const f32x2 hi = __builtin_amdgcn_cvt_pk_f32_fp8((int)(W)[k], true);           \
        acc[(AB) + k * 4 + 0] += a_ * lo[0]; acc[(AB) + k * 4 + 1] += a_ * lo[1];      \
        acc[(AB) + k * 4 + 2] += a_ * hi[0]; acc[(AB) + k * 4 + 3] += a_ * hi[1];      \
      } }
#define P9_STEP(S, e_) {                                                               \
      const int e = (e_);                                                              \
      f32x2 d_A = {0.f, 0.f}, d_B = {0.f, 0.f};                                        \
      P9_DOT8(U##S##0, 0, d_)                                                          \
      P9_DOT8(U##S##1, 4, d_)                                                          \
      float d_ = (d_A[0] + d_A[1]) + (d_B[0] + d_B[1]);                                \
      const float gt_ = (e < 64) ? rdl(g0, e & 63) : rdl(g1, e & 63);                  \
      const int en_ = (e + 4) & 127;                                                   \
      const int idn_ = (en_ < 64) ? __builtin_amdgcn_readlane(id0, en_ & 63) : __builtin_amdgcn_readlane(id1, en_ & 63); \
      __builtin_amdgcn_sched_barrier(0);                                               \
      P9_LDU(S, idn_)                                                                  \
      __builtin_amdgcn_sched_barrier(0);                                               \
      d_ = wave_sum(d_);                                                               \
      const float a_ = gelu_tanh(d_ * (1.f / U_SCALE)) * gt_ * (1.f / V_SCALE);        \
      P9_AXPY8(V##S##0, 0, a_)                                                         \
      P9_AXPY8(V##S##1, 16, a_)                                                        \
      __builtin_amdgcn_sched_barrier(0);                                               \
      P9_LDV(S, idn_)                                                                  \
      __builtin_amdgcn_sched_barrier(0);                                               \
    }
    {
      const int i0_ = __builtin_amdgcn_readlane(id0, 0), i1_ = __builtin_amdgcn_readlane(id0, 1), i2_ = __builtin_amdgcn_readlane(id0, 2), i3_ = __builtin_amdgcn_readlane(id0, 3);
      P9_LDU(0, i0_) P9_LDV(0, i0_) P9_LDU(1, i1_) P9_LDV(1, i1_) P9_LDU(2, i2_) P9_LDV(2, i2_) P9_LDU(3, i3_) P9_LDV(3, i3_)
    }
#pragma unroll 1
    for (int eb = 0; eb < 128; eb += 4) {
      P9_STEP(0, eb)
      P9_STEP(1, eb + 1)
      P9_STEP(2, eb + 2)
      P9_STEP(3, eb + 3)
    }
#undef P9_LDU
#undef P9_LDV
#undef P9_DOT8
#undef P9_AXPY8
#undef P9_STEP
    float s = 0.f;
#pragma unroll
    for (int jq = 0; jq < 8; ++jq) {
      const f32x4 xv = xs[jq * 64 + lane];
#pragma unroll
      for (int c = 0; c < 4; ++c) { acc[jq * 4 + c] = DN_ALPHA * xv[c] + acc[jq * 4 + c]; s += acc[jq * 4 + c]; }
    }
    const float mean = wave_sum(s) * (1.f / 2048.f);
    float qv = 0.f;
#pragma unroll
    for (int i = 0; i < 32; ++i) { acc[i] -= mean; qv += acc[i] * acc[i]; }
    const float rstd = rsqrtf(wave_sum(qv) * (1.f / 2048.f) + 1e-5f);
    const int lz9 = lane + opaque0();
#pragma unroll
    for (int i = 0; i < 2; ++i) {
      const int c0 = i * 1024 + lz9 * 16;
      float o[16];
#pragma unroll
      for (int k = 0; k < 4; ++k) {
        const f32x4 gg = *(const f32x4*)(SPF + SP_LN2G + c0 + k * 4);
        const f32x4 bb = *(const f32x4*)(SPF + SP_LN2B + c0 + k * 4);
#pragma unroll
        for (int j = 0; j < 4; ++j) o[k * 4 + j] = acc[i * 16 + k * 4 + j] * rstd * gg[j] + bb[j];
        *(float4*)(h2 + (size_t)t * 2048 + c0 + k * 4) = float4{o[k * 4], o[k * 4 + 1], o[k * 4 + 2], o[k * 4 + 3]};
      }
      uint4 w0, w1;
      w0.x = pack2(o[0], o[1]); w0.y = pack2(o[2], o[3]); w0.z = pack2(o[4], o[5]); w0.w = pack2(o[6], o[7]);
      w1.x = pack2(o[8], o[9]); w1.y = pack2(o[10], o[11]); w1.z = pack2(o[12], o[13]); w1.w = pack2(o[14], o[15]);
      *(uint4*)(h2b + (size_t)t * 2048 + c0) = w0;
      *(uint4*)(h2b + (size_t)t * 2048 + c0 + 8) = w1;
    }
  }
}

__device__ void phase10(const Params& P, char* smem) {
  char* ws = P.ws;
  const u16* h2b = (const u16*)(ws + OFF_A4 + A4_H2B);
  const float* h2 = (const float*)(ws + OFF_A3);
  const u16* pb = (const u16*)(ws + OFF_PB);
  const u16* wg = (const u16*)(ws + OFF_WPG);
  const u16* wp = (const u16*)(ws + OFF_WPP);
  float* ppb = (float*)(ws + OFF_A2);
  const int tid = threadIdx.x, lane = tid & 63, wave = tid >> 6, wm = wave >> 1, wn = wave & 1;
  for (int tile = blockIdx.x; tile < 32 * 16; tile += P.nblk) {
    const int mt = tile & 31, nt = tile >> 5;
    const int m0 = mt * 256, n0 = nt * 128;
    f32x4 acc[8][4];
    zero_acc8(acc);
    gemm_mainloop_big(acc, pb + (size_t)m0 * 256, 256, wp + (size_t)n0 * 256, 256, 256, smem);
    EPIV8_BEGIN EPIV8_INNER
      *(f32x4*)(ppb + (size_t)(m0 + lrow) * 2048 + n0 + lcol0) = acc[mi][ni];
    EPIV_INNER_END EPIV_END
    zero_acc8(acc);
    gemm_mainloop_big(acc, h2b + (size_t)m0 * 2048, 2048, wg + (size_t)n0 * 2048, 2048, 2048, smem);
    EPIV8_BEGIN
      f32x4 hv[4], pv[4];
      EPIV8_INNER
        hv[ni] = *(const f32x4*)(h2 + (size_t)(m0 + lrow) * 2048 + n0 + lcol0);
        pv[ni] = *(const f32x4*)(ppb + (size_t)(m0 + lrow) * 2048 + n0 + lcol0);
      EPIV_INNER_END
      EPIV_MID
      EPIV8_INNER
        *(f32x4*)(P.out + (size_t)(m0 + lrow) * 2048 + n0 + lcol0) = hv[ni] + sigmoid4(acc[mi][ni]) * pv[ni];
      EPIV_INNER_END
    EPIV_END
  }
}

constexpr int N_PHASES = 11;


#define XB_TMO      128
#define XB_XCNT(j)  (256  + 64 * (j))
#define XB_XSUB(j)  (1280 + 64 * (j))
#define XB_XGEN(j)  (2304 + 64 * (j))
#define XB_TOP      3328
#define XB_TOPGEN   3392
#define XCD_BAR_WORDS 3456
#define XB_SPIN_CAP (1u << 18)
#define LAS __attribute__((address_space(3)))
__device__ __forceinline__ unsigned xb_ld(unsigned* p)              { return __hip_atomic_load(p, __ATOMIC_RELAXED, __HIP_MEMORY_SCOPE_AGENT); }
__device__ __forceinline__ unsigned xb_add(unsigned* p, unsigned v) { return __hip_atomic_fetch_add(p, v, __ATOMIC_RELAXED, __HIP_MEMORY_SCOPE_AGENT); }
__device__ __forceinline__ unsigned xb_xcc_id() { return (unsigned)__builtin_amdgcn_s_getreg((3 << 11) | 20) & 0xFu; }
#define XB_SPIN(cond, bar) do { unsigned _sp = 0; while (cond) { __builtin_amdgcn_s_sleep(1); \
    if ((++_sp & 255u) == 0u) { if (xb_ld(&(bar)[XB_TMO])) break; if (_sp > XB_SPIN_CAP) { atomicAdd(&(bar)[XB_TMO], 1u); break; } } } } while (0)
struct XcdBarrier { unsigned* bar; unsigned x; volatile LAS unsigned* st; unsigned grid; };
__device__ __forceinline__ XcdBarrier xcd_barrier_post(unsigned* bar, volatile LAS unsigned* st) {
  XcdBarrier b; b.bar = bar; b.x = xb_xcc_id(); b.st = st; b.grid = 0u;
  if (threadIdx.x == 0) (void)xb_add(&bar[XB_XCNT(b.x)], 1u);
  return b;
}
__device__ __forceinline__ void xcd_barrier_complete(unsigned* bar, unsigned x, unsigned& nloc, unsigned& nx, const unsigned xb_grid) {
  const unsigned G = xb_grid;
  unsigned sum, cnt, mine, sp = 0u;
  for (;;) {
    sum = 0u; cnt = 0u; mine = 0u;
#pragma unroll
    for (unsigned j = 0; j < 16; ++j) { const unsigned c = xb_ld(&bar[XB_XCNT(j)]); sum += c; cnt += (c > 0u) ? 1u : 0u; mine = (j == x) ? c : mine; }
    if (sum == G) break;
    __builtin_amdgcn_s_sleep(1);
    if ((++sp & 255u) == 0u) { if (xb_ld(&bar[XB_TMO])) break; if (sp > XB_SPIN_CAP) { atomicAdd(&bar[XB_TMO], 1u); break; } }
  }
  nloc = mine > 0u ? mine : 1u; nx = cnt > 0u ? cnt : 1u;
}
__device__ __forceinline__ void xcd_barrier(const XcdBarrier& b) {
  asm volatile("s_waitcnt vmcnt(0)" ::: "memory");
  __syncthreads();
  if (threadIdx.x == 0) {
    unsigned* bar = b.bar;
    __builtin_amdgcn_s_waitcnt(0);
    unsigned nloc = b.st[0], nx = b.st[1];
    if (nloc == 0u) { xcd_barrier_complete(bar, b.x, nloc, nx, b.grid); b.st[0] = nloc; b.st[1] = nx; }
    const unsigned old = xb_add(&bar[XB_XSUB(b.x)], 1u);
    const unsigned gen = old / nloc;
    if (old + 1u == (gen + 1u) * nloc) {
      __builtin_amdgcn_fence(__ATOMIC_RELEASE, "agent");
      asm volatile("s_waitcnt vmcnt(0)" ::: "memory");
      const unsigned og = xb_add(&bar[XB_TOP], 1u);
      const unsigned tg = og / nx;
      if (og + 1u == (tg + 1u) * nx) xb_add(&bar[XB_TOPGEN], 1u);
      else XB_SPIN(xb_ld(&bar[XB_TOPGEN]) == tg, bar);
      __builtin_amdgcn_fence(__ATOMIC_ACQUIRE, "agent");
      xb_add(&bar[XB_XGEN(b.x)], 1u);
      asm volatile("s_waitcnt vmcnt(0)" ::: "memory");
    } else {
      XB_SPIN(xb_ld(&bar[XB_XGEN(b.x)]) == gen, bar);
      __builtin_amdgcn_fence(__ATOMIC_ACQUIRE, "agent");
      asm volatile("s_waitcnt vmcnt(0)" ::: "memory");
    }
  }
  __syncthreads();
}

template <int MODE>
__global__ void __launch_bounds__(256, 2) mega(Params P) {
  __shared__ __attribute__((aligned(16))) char smem[SMEM_BYTES];
  __shared__ uint4 xb_words;
  if (MODE < 0) {
    if (threadIdx.x == 0) xb_words = make_uint4(0u, 0u, 0u, 0u);
    __syncthreads();
    (void)xcd_barrier_post((unsigned*)(P.ws + OFF_BAR), (volatile LAS unsigned*)&xb_words);
  }
#define XB_HERE() XcdBarrier{(unsigned*)(P.ws + OFF_BAR), xb_xcc_id(), (volatile LAS unsigned*)&xb_words, (unsigned)P.nblk}
#define RUN_PHASE(n, fn)                                              \
  if (MODE < 0 || MODE == n) {                                        \
    fn(P, smem);                                                      \
    if (MODE < 0 && n + 1 < N_PHASES) {                               \
      if (P.ws == nullptr) cg::this_grid().sync(); else xcd_barrier(XB_HERE()); \
    }                                                                 \
  }
  RUN_PHASE(0, phase0)
  RUN_PHASE(1, phase1)
  RUN_PHASE(2, phase1c)
  RUN_PHASE(3, phase2)
  RUN_PHASE(4, phase3)
  RUN_PHASE(5, phase4b)
  RUN_PHASE(6, phase5)
  RUN_PHASE(7, phase6)
  RUN_PHASE(8, phase7)
  RUN_PHASE(9, phase9)
  RUN_PHASE(10, phase10)
}

template <int PH>
static void launch_phase(Params P, hipStream_t stream) {
  P.nblk = 512;
  hipLaunchKernelGGL(mega<PH>, dim3(512), dim3(256), 0, stream, P);
}

extern "C" void kernel_launch(void* const* d_in, const int* in_sizes, int n_in, void* d_out, int out_size,
                              void* d_ws, size_t ws_size, hipStream_t stream) {
  Params P{};
  const float** pp = (const float**)&P;
  for (int i = 0; i < 30; ++i) pp[i] = (const float*)d_in[i];
  P.out = (float*)d_out;
  P.ws = (char*)d_ws;
  if (ws_size < OFF_END2) {
    fprintf(stderr, "workspace too small: %zu < %zu\n", ws_size, (size_t)OFF_END2);
    return;
  }
#if COOP_LAUNCH
  static int grid_blocks = 0;
  if (!grid_blocks) {
    int dev = 0, cus = 0, per_cu = 0;
    hipGetDevice(&dev);
    hipDeviceGetAttribute(&cus, hipDeviceAttributeMultiprocessorCount, dev);
    hipOccupancyMaxActiveBlocksPerMultiprocessor(&per_cu, mega<-1>, 256, 0);
    grid_blocks = cus * per_cu;
  }
  hipMemsetAsync((char*)d_ws + OFF_BAR, 0, XCD_BAR_WORDS * 4 + 256, stream);
  P.nblk = grid_blocks;
  void* args[] = {&P};
  hipError_t e = hipLaunchCooperativeKernel((void*)mega<-1>, dim3(grid_blocks), dim3(256), args, 0, stream);
  if (e != hipSuccess) fprintf(stderr, "cooperative launch failed: %s (grid %d)\n", hipGetErrorString(e), grid_blocks);
#else
  launch_phase<0>(P, stream);
  launch_phase<1>(P, stream);
  launch_phase<2>(P, stream);
  launch_phase<3>(P, stream);
  launch_phase<4>(P, stream);
  launch_phase<5>(P, stream);
  launch_phase<6>(P, stream);
  launch_phase<7>(P, stream);
  launch_phase<8>(P, stream);
  launch_phase<9>(P, stream);
  launch_phase<10>(P, stream);
#endif
}
```

```cpp
#include <hip/hip_runtime.h>
#include <hip/hip_bf16.h>
#include <hip/hip_cooperative_groups.h>
#include <cstdio>
namespace cg = cooperative_groups;

typedef unsigned short u16;
using bf16x8 = __attribute__((ext_vector_type(8))) short;
using f32x4 = __attribute__((ext_vector_type(4))) float;
using f32x2 = __attribute__((ext_vector_type(2))) float;
typedef unsigned u32x4v __attribute__((ext_vector_type(4)));

#ifndef COOP_LAUNCH
#define COOP_LAUNCH 1
#endif

constexpr int T_TOK = 8192;
constexpr int DM = 2048;
constexpr int NWIN = 9344;
constexpr float DN_ALPHA = 1.189207115002721f;
constexpr int SMEM_BYTES = 73728 + 16;
constexpr float U_SCALE = 512.f, V_SCALE = 64.f;

constexpr size_t OFF_WIN  = 0;
constexpr size_t OFF_WGLU = OFF_WIN  + (size_t)NWIN * 2048 * 2;
constexpr size_t OFF_WUPS = OFF_WGLU + (size_t)1024 * 1024 * 2;
constexpr size_t OFF_WUPM = OFF_WUPS + (size_t)2048 * 1024 * 2;
constexpr size_t OFF_WOUT = OFF_WUPM + (size_t)2048 * 1024 * 2;
constexpr size_t OFF_WQ   = OFF_WOUT + (size_t)2048 * 2048 * 2;
constexpr size_t OFF_WPG  = OFF_WQ   + (size_t)2048 * 2048 * 2;
constexpr size_t OFF_WPP  = OFF_WPG  + (size_t)2048 * 2048 * 2;
constexpr size_t OFF_KEYS = OFF_WPP  + (size_t)2048 * 256 * 2;
constexpr size_t OFF_UB   = OFF_KEYS + (size_t)8 * 2 * 128 * 128 * 2;
constexpr size_t OFF_VB   = OFF_UB   + (size_t)16384 * 2048 * 2;
constexpr size_t OFF_S5P  = OFF_VB   + (size_t)16384 * 2048 * 2;
constexpr size_t OFF_PB   = OFF_S5P  + (size_t)(4096 * 2 + 65536 * 2) * 4;
constexpr size_t OFF_IF   = OFF_PB   + (size_t)T_TOK * 256 * 2;
constexpr size_t OFF_A0   = OFF_IF   + (size_t)T_TOK * 16 * 4;
constexpr size_t OFF_A1   = OFF_A0   + (size_t)T_TOK * 2048 * 2;
constexpr size_t OFF_A2   = OFF_A1   + (size_t)T_TOK * 1024 * 4;
constexpr size_t OFF_A3   = OFF_A2   + (size_t)T_TOK * 4096 * 2;
constexpr size_t OFF_A4   = OFF_A3   + (size_t)T_TOK * 4096 * 2;
constexpr size_t OFF_END  = OFF_A4   + (size_t)T_TOK * 4096 * 2;
constexpr size_t OFF_SP   = OFF_END;
constexpr int SP_BIG = 0, SP_BFG = 8, SP_CONV = 16, SP_MHW = SP_CONV + 8192, SP_CRE = SP_MHW + 1024, SP_CIM = SP_CRE + 65536,
              SP_SSMD = SP_CIM + 65536, SP_BGLU = SP_SSMD + 1024, SP_LN1G = SP_BGLU + 1024, SP_LN1B = SP_LN1G + 2048,
              SP_LN2G = SP_LN1B + 2048, SP_LN2B = SP_LN2G + 2048, SP_TOTAL = SP_LN2B + 2048;
constexpr size_t OFF_BAR  = ((OFF_SP + (size_t)SP_TOTAL * 4 + 255) / 256) * 256;
constexpr size_t OFF_TCTR = OFF_BAR + 3456 * 4;
constexpr size_t OFF_QKC  = OFF_TCTR + 256;
constexpr size_t OFF_END2 = OFF_QKC + (size_t)T_TOK * 2048 * 2;
constexpr size_t A4_HM    = (size_t)T_TOK * 1024 * 2;
constexpr size_t A4_TOPI  = (size_t)T_TOK * 256 * 4;
constexpr size_t A4_H2B   = (size_t)T_TOK * 1024 * 2;

struct Params {
  const float *x, *p, *w_in, *b_ig, *b_fg, *conv_qk, *mh_norm_w, *a_re, *a_im, *log_dt, *b_re, *b_im,
      *c_re, *c_im, *ssm_d, *w_glu, *b_glu, *w_up_ssm, *w_up_ml, *w_out, *ln1_g, *ln1_b, *peer_wq,
      *peer_keys, *peer_u, *peer_v, *ln2_g, *ln2_b, *ple_wg, *ple_wp;
  float* out;
  char* ws;
  int nblk;
  int pad_;
};

typedef __bf16 bf16x2_t __attribute__((ext_vector_type(2)));
__device__ __forceinline__ unsigned pack2(float a, float b) {
  const f32x2 v = {a, b};
  return __builtin_bit_cast(unsigned, __builtin_convertvector(v, bf16x2_t));
}
__device__ __forceinline__ u16 f2bf(float f) { return (u16)(pack2(f, 0.f) & 0xffffu); }
__device__ __forceinline__ float bf2f(u16 h) { return __uint_as_float(((unsigned)h) << 16); }
__device__ __forceinline__ float bflo(unsigned u) { return __uint_as_float(u << 16); }
__device__ __forceinline__ float bfhi(unsigned u) { return __uint_as_float(u & 0xffff0000u); }
__device__ __forceinline__ float sigmoidf_(float x) { return __builtin_amdgcn_rcpf(1.f + __expf(-x)); }
__device__ __forceinline__ float gelu_tanh(float x) {
  float u = 0.7978845608028654f * (x + 0.044715f * x * x * x);
  float t = 1.f - 2.f * __builtin_amdgcn_rcpf(1.f + __expf(2.f * u));
  return 0.5f * x * (1.f + t);
}
template <int CTRL> __device__ __forceinline__ float dpp_f(float v) {
  return __builtin_bit_cast(float, __builtin_amdgcn_update_dpp(0, __builtin_bit_cast(int, v), CTRL, 0xF, 0xF, false));
}
__device__ __forceinline__ float rdl(float v, int l) { return __builtin_bit_cast(float, __builtin_amdgcn_readlane(__builtin_bit_cast(int, v), l)); }
__device__ __forceinline__ float row_sum(float v) {
  v += dpp_f<0xB1>(v); v += dpp_f<0x4E>(v); v += dpp_f<0x141>(v); v += dpp_f<0x140>(v);
  return v;
}
__device__ __forceinline__ float row_max(float v) {
  v = fmaxf(v, dpp_f<0xB1>(v)); v = fmaxf(v, dpp_f<0x4E>(v)); v = fmaxf(v, dpp_f<0x141>(v)); v = fmaxf(v, dpp_f<0x140>(v));
  return v;
}
template <int CTRL, int ROWMASK> __device__ __forceinline__ float dpp_fm(float old, float v) {
  return __builtin_bit_cast(float, __builtin_amdgcn_update_dpp(__builtin_bit_cast(int, old), __builtin_bit_cast(int, v), CTRL, ROWMASK, 0xF, false));
}
__device__ __forceinline__ float wave_scan_sum(float v) {
  v += dpp_fm<0x111, 0xF>(0.f, v);
  v += dpp_fm<0x112, 0xF>(0.f, v);
  v += dpp_fm<0x114, 0xF>(0.f, v);
  v += dpp_fm<0x118, 0xF>(0.f, v);
  v += dpp_fm<0x142, 0xA>(0.f, v);
  v += dpp_fm<0x143, 0xC>(0.f, v);
  return v;
}
__device__ __forceinline__ float wave_scan_max(float v) {
  const float ninf = -3.0e38f;
  v = fmaxf(v, dpp_fm<0x111, 0xF>(ninf, v));
  v = fmaxf(v, dpp_fm<0x112, 0xF>(ninf, v));
  v = fmaxf(v, dpp_fm<0x114, 0xF>(ninf, v));
  v = fmaxf(v, dpp_fm<0x118, 0xF>(ninf, v));
  v = fmaxf(v, dpp_fm<0x142, 0xA>(ninf, v));
  v = fmaxf(v, dpp_fm<0x143, 0xC>(ninf, v));
  return v;
}
__device__ __forceinline__ float wave_sum(float v) {
  v = row_sum(v);
  return (rdl(v, 0) + rdl(v, 16)) + (rdl(v, 32) + rdl(v, 48));
}
__device__ __forceinline__ float wave_max(float v) {
  v = row_max(v);
  return fmaxf(fmaxf(rdl(v, 0), rdl(v, 16)), fmaxf(rdl(v, 32), rdl(v, 48)));
}
__device__ __forceinline__ f32x4 mfma16(bf16x8 a, bf16x8 b, f32x4 c) {
  return __builtin_amdgcn_mfma_f32_16x16x32_bf16(a, b, c, 0, 0, 0);
}

template <int DEPTH = 1>
__device__ __forceinline__ void gemm_mainloop(f32x4 (&acc)[4][4], const u16* __restrict__ A, int lda,
                                              const u16* __restrict__ Bt, int ldb, int K, char* smem) {
  u16* As = (u16*)smem;
  u16* Bs = As + 2 * 128 * 64;
  const int tid = threadIdx.x, lane = tid & 63, wave = tid >> 6, wm = wave >> 1, wn = wave & 1;
  const int lr = tid >> 3, lc = (tid & 7) * 8;
  const int lcs = ((tid & 7) ^ ((lr >> 1) & 7)) * 8;
  const int sw = (lane & 15) >> 1;
  const int fo0 = (lane & 15) * 64 + (((lane >> 4) ^ sw) * 8), fo1 = (lane & 15) * 64 + ((((lane >> 4) ^ sw) ^ 4) * 8);
  u32x4v ra0, ra1, ra2, ra3, rb0, rb1, rb2, rb3;
  u32x4v qa0, qa1, qa2, qa3, qb0, qb1, qb2, qb3;
  const __amdgpu_buffer_rsrc_t rsA = __builtin_amdgcn_make_buffer_rsrc((void*)A, 0, 0x7fffffff, 0x00020000);
  const __amdgpu_buffer_rsrc_t rsB = __builtin_amdgcn_make_buffer_rsrc((void*)Bt, 0, 0x7fffffff, 0x00020000);
  const int oa0 = (int)(((size_t)lr * lda + lc) * 2), oa1 = oa0 + 64 * lda, oa2 = oa0 + 128 * lda, oa3 = oa0 + 192 * lda;
  const int ob0 = (int)(((size_t)lr * ldb + lc) * 2), ob1 = ob0 + 64 * ldb, ob2 = ob0 + 128 * ldb, ob3 = ob0 + 192 * ldb;
#define GL_LOAD_X(k0) {                                                              \
  const int ko_ = (int)(k0) * 2;                                                     \
  ra0 = __builtin_amdgcn_raw_buffer_load_b128(rsA, oa0, ko_, 0); rb0 = __builtin_amdgcn_raw_buffer_load_b128(rsB, ob0, ko_, 0); \
  ra1 = __builtin_amdgcn_raw_buffer_load_b128(rsA, oa1, ko_, 0); rb1 = __builtin_amdgcn_raw_buffer_load_b128(rsB, ob1, ko_, 0); \
  ra2 = __builtin_amdgcn_raw_buffer_load_b128(rsA, oa2, ko_, 0); rb2 = __builtin_amdgcn_raw_buffer_load_b128(rsB, ob2, ko_, 0); \
  ra3 = __builtin_amdgcn_raw_buffer_load_b128(rsA, oa3, ko_, 0); rb3 = __builtin_amdgcn_raw_buffer_load_b128(rsB, ob3, ko_, 0); }
#define GL_LOAD_Y(k0) {                                                              \
  const int ko_ = (int)(k0) * 2;                                                     \
  qa0 = __builtin_amdgcn_raw_buffer_load_b128(rsA, oa0, ko_, 0); qb0 = __builtin_amdgcn_raw_buffer_load_b128(rsB, ob0, ko_, 0); \
  qa1 = __builtin_amdgcn_raw_buffer_load_b128(rsA, oa1, ko_, 0); qb1 = __builtin_amdgcn_raw_buffer_load_b128(rsB, ob1, ko_, 0); \
  qa2 = __builtin_amdgcn_raw_buffer_load_b128(rsA, oa2, ko_, 0); qb2 = __builtin_amdgcn_raw_buffer_load_b128(rsB, ob2, ko_, 0); \
  qa3 = __builtin_amdgcn_raw_buffer_load_b128(rsA, oa3, ko_, 0); qb3 = __builtin_amdgcn_raw_buffer_load_b128(rsB, ob3, ko_, 0); }
#define LDS_STORE_X(Ad, Bd)                                                          \
  *(u32x4v*)((Ad) + (lr) * 64 + lcs) = ra0;      *(u32x4v*)((Bd) + (lr) * 64 + lcs) = rb0;      \
  *(u32x4v*)((Ad) + (lr + 32) * 64 + lcs) = ra1; *(u32x4v*)((Bd) + (lr + 32) * 64 + lcs) = rb1; \
  *(u32x4v*)((Ad) + (lr + 64) * 64 + lcs) = ra2; *(u32x4v*)((Bd) + (lr + 64) * 64 + lcs) = rb2; \
  *(u32x4v*)((Ad) + (lr + 96) * 64 + lcs) = ra3; *(u32x4v*)((Bd) + (lr + 96) * 64 + lcs) = rb3;
#define LDS_STORE_Y(Ad, Bd)                                                          \
  *(u32x4v*)((Ad) + (lr) * 64 + lcs) = qa0;      *(u32x4v*)((Bd) + (lr) * 64 + lcs) = qb0;      \
  *(u32x4v*)((Ad) + (lr + 32) * 64 + lcs) = qa1; *(u32x4v*)((Bd) + (lr + 32) * 64 + lcs) = qb1; \
  *(u32x4v*)((Ad) + (lr + 64) * 64 + lcs) = qa2; *(u32x4v*)((Bd) + (lr + 64) * 64 + lcs) = qb2; \
  *(u32x4v*)((Ad) + (lr + 96) * 64 + lcs) = qa3; *(u32x4v*)((Bd) + (lr + 96) * 64 + lcs) = qb3;
#define MMA_STEP(Ab, Bb)                                                             \
  __builtin_amdgcn_s_setprio(1);                                                     \
  _Pragma("unroll") for (int ks = 0; ks < 2; ++ks) {                                 \
    bf16x8 af[4], bfr[4];                                                            \
    const int fo_ = ks ? fo1 : fo0;                                                  \
    _Pragma("unroll") for (int mi = 0; mi < 4; ++mi)                                 \
      af[mi] = *(const bf16x8*)((Ab) + (wm * 64 + mi * 16) * 64 + fo_);              \
    _Pragma("unroll") for (int ni = 0; ni < 4; ++ni)                                 \
      bfr[ni] = *(const bf16x8*)((Bb) + (wn * 64 + ni * 16) * 64 + fo_);             \
    _Pragma("unroll") for (int mi = 0; mi < 4; ++mi)                                 \
    _Pragma("unroll") for (int ni = 0; ni < 4; ++ni) acc[mi][ni] = mfma16(bfr[ni], af[mi], acc[mi][ni]); \
  }                                                                                  \
  __builtin_amdgcn_s_setprio(0);
  u16* As1 = As + 128 * 64;
  u16* Bs1 = Bs + 128 * 64;
  const int nk = K >> 6;
  if (DEPTH == 1) {
    GL_LOAD_X(0)
    LDS_STORE_X(As, Bs)
    __syncthreads();
    for (int kt = 0; kt < nk; kt += 2) {
      GL_LOAD_X((kt + 1) << 6)
      __builtin_amdgcn_sched_barrier(0);
      MMA_STEP(As, Bs)
      __builtin_amdgcn_sched_barrier(0);
      LDS_STORE_X(As1, Bs1)
      __syncthreads();
      if (kt + 2 < nk) { GL_LOAD_X((kt + 2) << 6) }
      __builtin_amdgcn_sched_barrier(0);
      MMA_STEP(As1, Bs1)
      __builtin_amdgcn_sched_barrier(0);
      if (kt + 2 < nk) { LDS_STORE_X(As, Bs) }
      __syncthreads();
    }
  } else {
    GL_LOAD_X(0)
    LDS_STORE_X(As, Bs)
    GL_LOAD_X(64)
    if (nk > 2) { GL_LOAD_Y(128) }
    __syncthreads();
    for (int kt = 0; kt < nk; kt += 2) {
      __builtin_amdgcn_sched_barrier(0);
      MMA_STEP(As, Bs)
      __builtin_amdgcn_sched_barrier(0);
      LDS_STORE_X(As1, Bs1)
      if (kt + 3 < nk) { GL_LOAD_X((kt + 3) << 6) }
      __syncthreads();
      __builtin_amdgcn_sched_barrier(0);
      MMA_STEP(As1, Bs1)
      __builtin_amdgcn_sched_barrier(0);
      if (kt + 2 < nk) { LDS_STORE_Y(As, Bs) }
      if (kt + 4 < nk) { GL_LOAD_Y((kt + 4) << 6) }
      __syncthreads();
    }
  }
#undef GL_LOAD_X
#undef GL_LOAD_Y
#undef LDS_STORE_X
#undef LDS_STORE_Y
#undef MMA_STEP
}

__device__ __forceinline__ void zero_acc(f32x4 (&acc)[4][4]) {
#pragma unroll
  for (int i = 0; i < 4; ++i)
#pragma unroll
    for (int j = 0; j < 4; ++j) acc[i][j] = f32x4{0.f, 0.f, 0.f, 0.f};
}

__device__ __forceinline__ int opaque0() {
  int z;
  asm volatile("v_mov_b32 %0, 0" : "=v"(z));
  return z;
}
#define EPIV_BEGIN {                                                            \
  const int lz = lane + opaque0();                                              \
  _Pragma("unroll") for (int mi = 0; mi < 4; ++mi) {
#define EPIV_INNER                                                              \
  _Pragma("unroll") for (int ni = 0; ni < 4; ++ni) {                            \
    const int lrow = wm * 64 + mi * 16 + (lz & 15);                             \
    const int lcol0 = wn * 64 + ni * 16 + (lz >> 4) * 4;
#define EPIV_INNER_END }
#define EPIV_MID __builtin_amdgcn_sched_barrier(0);
#define EPIV_END __builtin_amdgcn_sched_barrier(0); } }
__device__ __forceinline__ uint2 pack4(f32x4 v) { uint2 r; r.x = pack2(v[0], v[1]); r.y = pack2(v[2], v[3]); return r; }
__device__ __forceinline__ f32x4 unpack4(uint2 u) { return f32x4{bflo(u.x), bfhi(u.x), bflo(u.y), bfhi(u.y)}; }
__device__ __forceinline__ f32x4 sigmoid4(f32x4 v) { return f32x4{sigmoidf_(v[0]), sigmoidf_(v[1]), sigmoidf_(v[2]), sigmoidf_(v[3])}; }


__device__ __forceinline__ void gemm_mainloop_big(f32x4 (&acc)[8][4], const u16* __restrict__ A, int lda,
                                                  const u16* __restrict__ Bt, int ldb, int K, char* smem) {
  u16* As = (u16*)smem;
  u16* Bs = As + 2 * 256 * 32;
  const int tid = threadIdx.x, lane = tid & 63, wave = tid >> 6, wm = wave >> 1, wn = wave & 1;
  const int r4 = tid >> 2;
  const int lcs = ((tid & 3) ^ ((0 - (r4 >> 2)) & 3)) * 8;
  const int fo = (lane & 15) * 32 + (((lane >> 4) ^ ((0 - ((lane & 15) >> 2)) & 3)) * 8);
  const __amdgpu_buffer_rsrc_t rsA = __builtin_amdgcn_make_buffer_rsrc((void*)A, 0, 0x7fffffff, 0x00020000);
  const __amdgpu_buffer_rsrc_t rsB = __builtin_amdgcn_make_buffer_rsrc((void*)Bt, 0, 0x7fffffff, 0x00020000);
  const int oa0 = (r4 * lda + (tid & 3) * 8) * 2, oa1 = oa0 + 128 * lda, oa2 = oa0 + 256 * lda, oa3 = oa0 + 384 * lda;
  const int ob0 = (r4 * ldb + (tid & 3) * 8) * 2, ob1 = ob0 + 128 * ldb;
  u32x4v a0, a1, a2, a3, b0, b1;
#define BG_LOAD(k0) {                                                                \
  const int ko_ = (int)(k0) * 2;                                                     \
  a0 = __builtin_amdgcn_raw_buffer_load_b128(rsA, oa0, ko_, 0); b0 = __builtin_amdgcn_raw_buffer_load_b128(rsB, ob0, ko_, 0); \
  a1 = __builtin_amdgcn_raw_buffer_load_b128(rsA, oa1, ko_, 0); b1 = __builtin_amdgcn_raw_buffer_load_b128(rsB, ob1, ko_, 0); \
  a2 = __builtin_amdgcn_raw_buffer_load_b128(rsA, oa2, ko_, 0);                      \
  a3 = __builtin_amdgcn_raw_buffer_load_b128(rsA, oa3, ko_, 0); }
#define BG_STORE(Ad, Bd)                                                             \
  *(u32x4v*)((Ad) + (r4) * 32 + lcs) = a0;       *(u32x4v*)((Ad) + (r4 + 64) * 32 + lcs) = a1;  \
  *(u32x4v*)((Ad) + (r4 + 128) * 32 + lcs) = a2; *(u32x4v*)((Ad) + (r4 + 192) * 32 + lcs) = a3; \
  *(u32x4v*)((Bd) + (r4) * 32 + lcs) = b0;       *(u32x4v*)((Bd) + (r4 + 64) * 32 + lcs) = b1;
#define BG_MMA(Ab, Bb) {                                                             \
    __builtin_amdgcn_s_setprio(1);                                                   \
    bf16x8 bfr[4];                                                                   \
    _Pragma("unroll") for (int ni = 0; ni < 4; ++ni)                                 \
      bfr[ni] = *(const bf16x8*)((Bb) + (wn * 64 + ni * 16) * 32 + fo);              \
    _Pragma("unroll") for (int mh = 0; mh < 2; ++mh) {                               \
      bf16x8 af[4];                                                                  \
      _Pragma("unroll") for (int mi = 0; mi < 4; ++mi)                               \
        af[mi] = *(const bf16x8*)((Ab) + (wm * 128 + (mh * 4 + mi) * 16) * 32 + fo); \
      _Pragma("unroll") for (int mi = 0; mi < 4; ++mi)                               \
      _Pragma("unroll") for (int ni = 0; ni < 4; ++ni)                               \
        acc[mh * 4 + mi][ni] = mfma16(bfr[ni], af[mi], acc[mh * 4 + mi][ni]);        \
    }                                                                                \
    __builtin_amdgcn_s_setprio(0); }
  u16* As1 = As + 256 * 32;
  u16* Bs1 = Bs + 128 * 32;
  const int nk = K >> 5;
  BG_LOAD(0)
  BG_STORE(As, Bs)
  __syncthreads();
  for (int kt = 0; kt < nk; kt += 2) {
    BG_LOAD((kt + 1) << 5)
    __builtin_amdgcn_sched_barrier(0);
    BG_MMA(As, Bs)
    __builtin_amdgcn_sched_barrier(0);
    BG_STORE(As1, Bs1)
    __syncthreads();
    if (kt + 2 < nk) { BG_LOAD((kt + 2) << 5) }
    __builtin_amdgcn_sched_barrier(0);
    BG_MMA(As1, Bs1)
    __builtin_amdgcn_sched_barrier(0);
    if (kt + 2 < nk) { BG_STORE(As, Bs) }
    __syncthreads();
  }
#undef BG_LOAD
#undef BG_STORE
#undef BG_MMA
}
__device__ __forceinline__ void zero_acc8(f32x4 (&acc)[8][4]) {
#pragma unroll
  for (int i = 0; i < 8; ++i)
#pragma unroll
    for (int j = 0; j < 4; ++j) acc[i][j] = f32x4{0.f, 0.f, 0.f, 0.f};
}
#define EPIV8_BEGIN {                                                           \
  const int lz = lane + opaque0();                                              \
  _Pragma("unroll") for (int mi = 0; mi < 8; ++mi) {
#define EPIV8_INNER                                                             \
  _Pragma("unroll") for (int ni = 0; ni < 4; ++ni) {                            \
    const int lrow = wm * 128 + mi * 16 + (lz & 15);                            \
    const int lcol0 = wn * 64 + ni * 16 + (lz >> 4) * 4;

__device__ void transpose_cvt(const float* __restrict__ src, int K, int N, u16* __restrict__ dst, int Npad,
                              int mode, char* smem, const int nb) {
  float* tile = (float*)smem;
  const int tid = threadIdx.x;
  const int nkt = K / 64, nnt = Npad / 64;
  for (int u = blockIdx.x; u < nkt * nnt; u += nb) {
    const int kt = u % nkt, nt = u / nkt;
    const int k0 = kt * 64, n0 = nt * 64;
#pragma unroll
    for (int i = 0; i < 4; ++i) {
      const int e = tid + i * 256;
      const int kk = e >> 4, nq = (e & 15) * 4;
      const int n = n0 + nq;
      int sc = n;
      if (mode == 1) sc = n < 5120 ? n : (n < 9216 ? n + 16 : (n < 9232 ? n - 9216 + 5120 : -1));
      float4 v = float4{0.f, 0.f, 0.f, 0.f};
      if (sc >= 0) v = *(const float4*)(src + (size_t)(k0 + kk) * N + sc);
      tile[kk * 65 + nq + 0] = v.x; tile[kk * 65 + nq + 1] = v.y; tile[kk * 65 + nq + 2] = v.z; tile[kk * 65 + nq + 3] = v.w;
    }
    __syncthreads();
#pragma unroll
    for (int i = 0; i < 8; ++i) {
      const int e = tid + i * 256;
      const int nn = e >> 5, kp = (e & 31) * 2;
      const unsigned w = pack2(tile[kp * 65 + nn], tile[(kp + 1) * 65 + nn]);
      *(unsigned*)(dst + (size_t)(n0 + nn) * K + k0 + kp) = w;
    }
    __syncthreads();
  }
}

__device__ void cvt_straight(const float* __restrict__ src, u16* __restrict__ dst, size_t n, const int nb) {
  const size_t n4 = n >> 2;
  for (size_t i = (size_t)blockIdx.x * 256 + threadIdx.x; i < n4; i += (size_t)nb * 256) {
    float4 v = ((const float4*)src)[i];
    uint2 o;
    o.x = pack2(v.x, v.y);
    o.y = pack2(v.z, v.w);
    ((uint2*)dst)[i] = o;
  }
}

__device__ void cvt_fp8(const float* __restrict__ src, unsigned char* __restrict__ dst, size_t n, float scale, const int nb) {
  const size_t n8 = n >> 3;
  for (size_t i = (size_t)blockIdx.x * 256 + threadIdx.x; i < n8; i += (size_t)nb * 256) {
    float4 a = ((const float4*)src)[2 * i], b = ((const float4*)src)[2 * i + 1];
    int w0 = 0, w1 = 0;
    w0 = __builtin_amdgcn_cvt_pk_fp8_f32(a.x * scale, a.y * scale, w0, false);
    w0 = __builtin_amdgcn_cvt_pk_fp8_f32(a.z * scale, a.w * scale, w0, true);
    w1 = __builtin_amdgcn_cvt_pk_fp8_f32(b.x * scale, b.y * scale, w1, false);
    w1 = __builtin_amdgcn_cvt_pk_fp8_f32(b.z * scale, b.w * scale, w1, true);
    uint2 o;
    o.x = (unsigned)w0;
    o.y = (unsigned)w1;
    ((uint2*)dst)[i] = o;
  }
}

__device__ __forceinline__ void cvt_fp8_chunk(const float* __restrict__ src, unsigned char* __restrict__ dst, float scale) {
#pragma unroll 2
  for (int it = 0; it < 32; ++it) {
    const size_t i = (size_t)it * 256 + threadIdx.x;
    float4 a = ((const float4*)src)[2 * i], b = ((const float4*)src)[2 * i + 1];
    int w0 = 0, w1 = 0;
    w0 = __builtin_amdgcn_cvt_pk_fp8_f32(a.x * scale, a.y * scale, w0, false);
    w0 = __builtin_amdgcn_cvt_pk_fp8_f32(a.z * scale, a.w * scale, w0, true);
    w1 = __builtin_amdgcn_cvt_pk_fp8_f32(b.x * scale, b.y * scale, w1, false);
    w1 = __builtin_amdgcn_cvt_pk_fp8_f32(b.z * scale, b.w * scale, w1, true);
    uint2 o;
    o.x = (unsigned)w0;
    o.y = (unsigned)w1;
    ((uint2*)dst)[i] = o;
  }
}

__device__ void phase0(const Params& P, char* smem) {
  char* ws = P.ws;
  transpose_cvt(P.w_in, 2048, 9232, (u16*)(ws + OFF_WIN), NWIN, 1, smem, P.nblk);
  transpose_cvt(P.w_glu, 1024, 1024, (u16*)(ws + OFF_WGLU), 1024, 0, smem, P.nblk);
  transpose_cvt(P.w_up_ssm, 1024, 2048, (u16*)(ws + OFF_WUPS), 2048, 0, smem, P.nblk);
  transpose_cvt(P.w_up_ml, 1024, 2048, (u16*)(ws + OFF_WUPM), 2048, 0, smem, P.nblk);
  transpose_cvt(P.w_out, 2048, 2048, (u16*)(ws + OFF_WOUT), 2048, 0, smem, P.nblk);
  transpose_cvt(P.peer_wq, 2048, 2048, (u16*)(ws + OFF_WQ), 2048, 0, smem, P.nblk);
  transpose_cvt(P.ple_wg, 2048, 2048, (u16*)(ws + OFF_WPG), 2048, 0, smem, P.nblk);
  transpose_cvt(P.ple_wp, 256, 2048, (u16*)(ws + OFF_WPP), 2048, 0, smem, P.nblk);
  cvt_straight(P.peer_keys, (u16*)(ws + OFF_KEYS), (size_t)8 * 2 * 128 * 128, P.nblk);
  cvt_straight(P.x, (u16*)(ws + OFF_A0), (size_t)T_TOK * 2048, P.nblk);
  cvt_straight(P.p, (u16*)(ws + OFF_PB), (size_t)T_TOK * 256, P.nblk);
  {
    float* sp = (float*)(ws + OFF_SP);
    const int gt = blockIdx.x * 256 + threadIdx.x, gs = P.nblk * 256;
    for (int i = gt; i < 8; i += gs) { sp[SP_BIG + i] = P.b_ig[i]; sp[SP_BFG + i] = P.b_fg[i]; }
    for (int i = gt; i < 8192; i += gs) sp[SP_CONV + i] = P.conv_qk[i];
    for (int i = gt; i < 1024; i += gs) { sp[SP_MHW + i] = P.mh_norm_w[i]; sp[SP_SSMD + i] = P.ssm_d[i]; sp[SP_BGLU + i] = P.b_glu[i]; }
    for (int i = gt; i < 65536; i += gs) { sp[SP_CRE + i] = P.c_re[i]; sp[SP_CIM + i] = P.c_im[i]; }
    for (int i = gt; i < 2048; i += gs) { sp[SP_LN1G + i] = P.ln1_g[i]; sp[SP_LN1B + i] = P.ln1_b[i]; sp[SP_LN2G + i] = P.ln2_g[i]; sp[SP_LN2B + i] = P.ln2_b[i]; }
  }
  if (blockIdx.x == 0 && threadIdx.x == 0) {
    const float** pt = (const float**)(ws + OFF_TCTR + 64);
    pt[0] = P.peer_u;
    pt[1] = P.peer_v;
  }
  float* lam_r = (float*)(ws + OFF_S5P);
  float* lam_i = lam_r + 4096;
  float* bbar_r = lam_i + 4096;
  float* bbar_i = bbar_r + 65536;
  for (int i = blockIdx.x * 256 + threadIdx.x; i < 4096; i += P.nblk * 256) {
    const int g = i >> 6;
    const double ar = P.a_re[i], ai = P.a_im[i];
    const double dt = (double)expf(P.log_dt[g]);
    const double mag = (double)expf((float)(dt * ar));
    const double ang = dt * ai;
    const double kq = rint(ang * 0.15915494309189535);
    const float red = (float)(ang - kq * 6.283185307179586);
    const double lr = mag * (double)cosf(red), li = mag * (double)sinf(red);
    const double den = ar * ar + ai * ai;
    const double zr = ((lr - 1.0) * ar + li * ai) / den;
    const double zi = (li * ar - (lr - 1.0) * ai) / den;
    lam_r[i] = (float)lr;
    lam_i[i] = (float)li;
#pragma unroll 4
    for (int c = 0; c < 16; ++c) {
      const double br = P.b_re[i * 16 + c], bi = P.b_im[i * 16 + c];
      bbar_r[i * 16 + c] = (float)(zr * br - zi * bi);
      bbar_i[i * 16 + c] = (float)(zr * bi + zi * br);
    }
  }
}

#define SPF ((const float*)(P.ws + OFF_SP))
template <int DEPTH>
__device__ __forceinline__ void p1_tile(const Params& P, char* smem, const int mt, const int nt) {
  char* ws = P.ws;
  const u16* xb = (const u16*)(ws + OFF_A0);
  const u16* wt = (const u16*)(ws + OFF_WIN);
  float* us = (float*)(ws + OFF_A1);
  u16* qkvo = (u16*)(ws + OFF_A2);
  u16* gates = (u16*)(ws + OFF_A3);
  float* ifg = (float*)(ws + OFF_IF);
  const int tid = threadIdx.x, lane = tid & 63, wave = tid >> 6, wm = wave >> 1, wn = wave & 1;
  {

    const int m0 = mt * 128, n0 = nt * 128;
    f32x4 acc[4][4];
    zero_acc(acc);
    gemm_mainloop<DEPTH>(acc, xb + (size_t)m0 * 2048, 2048, wt + (size_t)n0 * 2048, 2048, 2048, smem);
    if (n0 < 1024) {
      EPIV_BEGIN EPIV_INNER
        *(f32x4*)(us + (size_t)(m0 + lrow) * 1024 + n0 + lcol0) = acc[mi][ni];
      EPIV_INNER_END EPIV_END
    } else if (n0 < 4096) {
      EPIV_BEGIN EPIV_INNER
        *(uint2*)(qkvo + (size_t)(m0 + lrow) * 4096 + (n0 - 1024) + lcol0) = pack4(acc[mi][ni]);
      EPIV_INNER_END EPIV_END
    } else if (n0 < 5120) {
      EPIV_BEGIN EPIV_INNER
        *(uint2*)(qkvo + (size_t)(m0 + lrow) * 4096 + (n0 - 1024) + lcol0) = pack4(sigmoid4(acc[mi][ni]));
      EPIV_INNER_END EPIV_END
    } else if (n0 < 9216) {
      EPIV_BEGIN EPIV_INNER
        *(uint2*)(gates + (size_t)(m0 + lrow) * 4096 + (n0 - 5120) + lcol0) = pack4(sigmoid4(acc[mi][ni]));
      EPIV_INNER_END EPIV_END
    } else {
      EPIV_BEGIN EPIV_INNER
        if (lcol0 < 16) {
          f32x4 v = acc[mi][ni];
#pragma unroll
          for (int j = 0; j < 4; ++j) v[j] += (lcol0 + j) < 8 ? (SPF + SP_BIG)[lcol0 + j] : (SPF + SP_BFG)[lcol0 + j - 8];
          *(f32x4*)(ifg + (size_t)(m0 + lrow) * 16 + lcol0) = v;
        }
      EPIV_INNER_END EPIV_END
    }
  }
}

__device__ void phase1(const Params& P, char* smem) {
  for (int tile = blockIdx.x; tile < 64 * 40; tile += P.nblk) {
    const int mt = tile & 63, i = tile >> 6;
    p1_tile<2>(P, smem, mt, i < 39 ? i : 72);
  }
}

__device__ void phase1c(const Params& P, char* smem) {
  char* ws = P.ws;
  const u16* qkvo = (const u16*)(ws + OFF_A2);
  u16* qkc = (u16*)(ws + OFF_QKC);
  const int gt = blockIdx.x * 256 + threadIdx.x, gs = P.nblk * 256;
  for (int item = gt; item < (T_TOK / 8) * 256; item += gs) {
    const int cg = item & 255, tb = item >> 8;
    const int col = cg * 8;
    const int tok0 = tb * 8, sp0 = tok0 & 2047;
    float cw[4][8];
#pragma unroll
    for (int j = 0; j < 4; ++j)
#pragma unroll
      for (int i = 0; i < 8; ++i) cw[j][i] = (SPF + SP_CONV)[j * 2048 + col + i];
    const float kscale = col >= 1024 ? 0.08838834764831845f : 1.f;
    const u16* base = qkvo + (size_t)(tok0 - sp0) * 4096 + col;
    float x0[8], x1[8], x2[8], x3[8];
    auto ldrow = [&](int sp, float (&dst)[8]) {
      if (sp >= 0) {
        uint4 r = *(const uint4*)(base + (size_t)sp * 4096);
        dst[0] = bflo(r.x); dst[1] = bfhi(r.x); dst[2] = bflo(r.y); dst[3] = bfhi(r.y);
        dst[4] = bflo(r.z); dst[5] = bfhi(r.z); dst[6] = bflo(r.w); dst[7] = bfhi(r.w);
      } else {
#pragma unroll
        for (int i = 0; i < 8; ++i) dst[i] = 0.f;
      }
    };
    ldrow(sp0 - 3, x0);
    ldrow(sp0 - 2, x1);
    ldrow(sp0 - 1, x2);
#pragma unroll
    for (int r = 0; r < 8; ++r) {
      ldrow(sp0 + r, x3);
      float o[8];
#pragma unroll
      for (int i = 0; i < 8; ++i) {
        float c = cw[0][i] * x0[i] + cw[1][i] * x1[i] + cw[2][i] * x2[i] + cw[3][i] * x3[i];
        o[i] = c * sigmoidf_(c) * kscale;
      }
      uint4 w;
      w.x = pack2(o[0], o[1]); w.y = pack2(o[2], o[3]); w.z = pack2(o[4], o[5]); w.w = pack2(o[6], o[7]);
      *(uint4*)(qkc + (size_t)(tok0 + r) * 2048 + col) = w;
#pragma unroll
      for (int i = 0; i < 8; ++i) { x0[i] = x1[i]; x1[i] = x2[i]; x2[i] = x3[i]; }
    }
  }
}

__device__ void s5_unit(const Params& P, int unit, char* smem) {
  char* ws = P.ws;
  const int tid = threadIdx.x, lane = tid & 63, wave = tid >> 6;
  const int b = unit >> 4, g = (unit & 15) * 4 + wave;
  float* BU = (float*)(smem + wave * 13568);
  u16* Sb = (u16*)(smem + wave * 13568 + 8192);
  const float* us = (const float*)(ws + OFF_A1);
  u16* yg = (u16*)(ws + OFF_A4);
  const float* lam_r = (const float*)(ws + OFF_S5P);
  const float* lam_i = lam_r + 4096;
  const float* bbar_r = lam_i + 4096;
  const float* bbar_i = bbar_r + 65536;
  const int l15 = lane & 15, lq = lane >> 4;
  bf16x8 bfr[8];
#pragma unroll
  for (int nt = 0; nt < 8; ++nt) {
    const int n = nt * 16 + l15;
    bf16x8 v = {0, 0, 0, 0, 0, 0, 0, 0};
    if (lq < 2) {
      const float* src = (n < 64) ? (bbar_r + ((size_t)(g * 64 + n) * 16 + lq * 8))
                                  : (bbar_i + ((size_t)(g * 64 + n - 64) * 16 + lq * 8));
#pragma unroll
      for (int jj = 0; jj < 8; ++jj) v[jj] = (short)f2bf(src[jj]);
    }
    bfr[nt] = v;
  }
  const float dsk = (SPF + SP_SSMD)[g * 16 + l15];
  bf16x8 cfr[5];
#pragma unroll
  for (int ks = 0; ks < 5; ++ks) {
    const int nb = ks * 32 + lq * 8;
    bf16x8 v;
#pragma unroll
    for (int jj = 0; jj < 8; ++jj) {
      const int n = nb + jj;
      float val;
      if (n < 64) val = (SPF + SP_CRE)[(size_t)(g * 16 + l15) * 64 + n];
      else if (n < 128) val = -(SPF + SP_CIM)[(size_t)(g * 16 + l15) * 64 + (n - 64)];
      else val = (n - 128 == l15) ? dsk : 0.f;
      v[jj] = (short)f2bf(val);
    }
    cfr[ks] = v;
  }
  const float lr = lam_r[g * 64 + lane], li = lam_i[g * 64 + lane];
  float sr = 0.f, si = 0.f;
  float4 pv0 = float4{0.f, 0.f, 0.f, 0.f}, pv1 = pv0;
  if (lq < 2) {
    const float* src = us + (size_t)(b * 2048 + l15) * 1024 + g * 16 + lq * 8;
    pv0 = *(const float4*)src; pv1 = *(const float4*)(src + 4);
  }
  for (int sc = 0; sc < 128; ++sc) {
    const int t0 = b * 2048 + sc * 16;
    {
      bf16x8 af;
      af[0] = (short)f2bf(pv0.x); af[1] = (short)f2bf(pv0.y); af[2] = (short)f2bf(pv0.z); af[3] = (short)f2bf(pv0.w);
      af[4] = (short)f2bf(pv1.x); af[5] = (short)f2bf(pv1.y); af[6] = (short)f2bf(pv1.z); af[7] = (short)f2bf(pv1.w);
      if (lq < 2 && sc + 1 < 128) {
        const float* src = us + (size_t)(t0 + 16 + l15) * 1024 + g * 16 + lq * 8;
        pv0 = *(const float4*)src; pv1 = *(const float4*)(src + 4);
      }
      *(bf16x8*)(Sb + l15 * 168 + 128 + lq * 8) = af;
#pragma unroll
      for (int nt = 0; nt < 8; ++nt) {
        f32x4 a = mfma16(af, bfr[nt], f32x4{0.f, 0.f, 0.f, 0.f});
#pragma unroll
        for (int jj = 0; jj < 4; ++jj) BU[(lq * 4 + jj) * 128 + nt * 16 + l15] = a[jj];
      }
    }
    __builtin_amdgcn_fence(__ATOMIC_RELEASE, "wavefront");
    __builtin_amdgcn_wave_barrier();
    __builtin_amdgcn_fence(__ATOMIC_ACQUIRE, "wavefront");
    {
      float bre[16], bim[16];
#pragma unroll
      for (int t = 0; t < 16; ++t) { bre[t] = BU[t * 128 + lane]; bim[t] = BU[t * 128 + 64 + lane]; }
#pragma unroll
      for (int t = 0; t < 16; ++t) {
        const float nsr = lr * sr - li * si + bre[t];
        const float nsi = lr * si + li * sr + bim[t];
        sr = nsr; si = nsi;
        bre[t] = sr; bim[t] = si;
      }
#pragma unroll
      for (int t = 0; t < 16; ++t) {
        Sb[t * 168 + lane] = f2bf(bre[t]);
        Sb[t * 168 + 64 + lane] = f2bf(bim[t]);
      }
    }
    __builtin_amdgcn_fence(__ATOMIC_RELEASE, "wavefront");
    __builtin_amdgcn_wave_barrier();
    __builtin_amdgcn_fence(__ATOMIC_ACQUIRE, "wavefront");
    {
      f32x4 a = {0.f, 0.f, 0.f, 0.f};
#pragma unroll
      for (int ks = 0; ks < 5; ++ks) {
        bf16x8 af = *(const bf16x8*)(Sb + l15 * 168 + ks * 32 + lq * 8);
        a = mfma16(af, cfr[ks], a);
      }
#pragma unroll
      for (int jj = 0; jj < 4; ++jj) {
        const size_t t = (size_t)t0 + lq * 4 + jj;
        yg[t * 1024 + g * 16 + l15] = f2bf(gelu_tanh(a[jj]));
      }
    }
    __builtin_amdgcn_fence(__ATOMIC_RELEASE, "wavefront");
    __builtin_amdgcn_wave_barrier();
    __builtin_amdgcn_fence(__ATOMIC_ACQUIRE, "wavefront");
  }
  __syncthreads();
}

__device__ __forceinline__ void lds_barrier() { asm volatile("s_waitcnt lgkmcnt(0)\n\ts_barrier" ::: "memory"); }

__device__ void mlstm_unit(const Params& P, int unit, char* smem) {
  char* ws = P.ws;
  const int b = unit >> 5, h = (unit >> 2) & 7, sl = unit & 3;
  u16* qs = (u16*)smem;
  u16* ks_ = qs + 64 * 136;
  u16* vT = ks_ + 64 * 136;
  u16* wvT = vT + 32 * 72;
  u16* scs = wvT + 32 * 72;
  u16* CT = scs + 64 * 72;
  float* fl = (float*)(CT + 32 * 136);
  float* es = fl;
  float* rts = fl + 64;
  float* isc = fl + 128;
  float* emr = fl + 192;
  float* wts = fl + 256;
  float* nst = fl + 320;
  float* qn = fl + 448;
  float* scal = fl + 512;
  u16* wtsb = (u16*)(fl + 520);
  u16* nT = wtsb + 64;
  const u16* qkvo = (const u16*)(ws + OFF_A2);
  const float* ifg = (const float*)(ws + OFF_IF);
  float* hm = (float*)(ws + OFF_A4 + A4_HM);
  const int tid = threadIdx.x, lane = tid & 63, wave = tid >> 6;
  const int l15 = lane & 15, lq = lane >> 4;
  const u16* qkc = (const u16*)(ws + OFF_QKC);
  const int vs = tid >> 2, vdq = (tid & 3) * 8;
  for (int i = tid; i < 32 * 136; i += 256) CT[i] = 0;
  if (tid < 128) { nst[tid] = 0.f; nT[tid] = 0; }
  f32x4 nacc[2];
  nacc[0] = f32x4{0.f, 0.f, 0.f, 0.f};
  nacc[1] = f32x4{0.f, 0.f, 0.f, 0.f};
  f32x4 stacc[2][2];
  stacc[0][0] = f32x4{0.f, 0.f, 0.f, 0.f}; stacc[0][1] = f32x4{0.f, 0.f, 0.f, 0.f};
  stacc[1][0] = f32x4{0.f, 0.f, 0.f, 0.f}; stacc[1][1] = f32x4{0.f, 0.f, 0.f, 0.f};
  float m_st = 0.f;
  uint4 pq0, pq1, pq2, pq3, pq4, pq5, pq6, pq7;
  uint4 pvv;
  float pig = 0.f, pfp = 0.f;
#define ML_PIECE_SRC(i, T0) (qkc + (size_t)((T0) + (((tid + (i) * 256) >> 4) & 63)) * 2048 + ((tid + (i) * 256) >> 10) * 1024 + h * 128 + ((tid + (i) * 256) & 15) * 8)
#define ML_PIECE_DST(i) ((((tid + (i) * 256) >> 10) ? ks_ : qs) + (((tid + (i) * 256) >> 4) & 63) * 136 + ((tid + (i) * 256) & 15) * 8)
#define ML_PREFETCH(T0) {                                                                          \
    pq0 = *(const uint4*)ML_PIECE_SRC(0, T0); pq1 = *(const uint4*)ML_PIECE_SRC(1, T0);            \
    pq2 = *(const uint4*)ML_PIECE_SRC(2, T0); pq3 = *(const uint4*)ML_PIECE_SRC(3, T0);            \
    pq4 = *(const uint4*)ML_PIECE_SRC(4, T0); pq5 = *(const uint4*)ML_PIECE_SRC(5, T0);            \
    pq6 = *(const uint4*)ML_PIECE_SRC(6, T0); pq7 = *(const uint4*)ML_PIECE_SRC(7, T0);            \
    pvv = *(const uint4*)(qkvo + (size_t)((T0) + vs) * 4096 + 2048 + h * 128 + sl * 32 + vdq);     \
    if (wave == 0) { pig = ifg[(size_t)((T0) + lane) * 16 + h]; pfp = ifg[(size_t)((T0) + lane) * 16 + 8 + h]; } }
  ML_PREFETCH(b * 2048)
  __syncthreads();
  for (int chunk = 0; chunk < 32; ++chunk) {
    const int t0 = b * 2048 + chunk * 64;
    *(uint4*)ML_PIECE_DST(0) = pq0; *(uint4*)ML_PIECE_DST(1) = pq1; *(uint4*)ML_PIECE_DST(2) = pq2; *(uint4*)ML_PIECE_DST(3) = pq3;
    *(uint4*)ML_PIECE_DST(4) = pq4; *(uint4*)ML_PIECE_DST(5) = pq5; *(uint4*)ML_PIECE_DST(6) = pq6; *(uint4*)ML_PIECE_DST(7) = pq7;
    float vreg[8];
    {
      vreg[0] = bflo(pvv.x); vreg[1] = bfhi(pvv.x); vreg[2] = bflo(pvv.y); vreg[3] = bfhi(pvv.y);
      vreg[4] = bflo(pvv.z); vreg[5] = bfhi(pvv.z); vreg[6] = bflo(pvv.w); vreg[7] = bfhi(pvv.w);
#pragma unroll
      for (int i = 0; i < 8; ++i) vT[(vdq + i) * 72 + vs] = f2bf(vreg[i]);
    }
    const float ig_c = pig, fp_c = pfp;
    if (chunk + 1 < 32) ML_PREFETCH(t0 + 64)
    if (wave == 0) {
      const float ig = ig_c;
      const float fp = fp_c;
      const float logf = fminf(fp, 0.f) - log1pf(__expf(-fabsf(fp)));
      const float bc = wave_scan_sum(logf);
      const float gtot = rdl(bc, 63);
      const float e = ig - bc;
      const float pm = wave_scan_max(e);
      const float mloc = gtot + rdl(pm, 63);
      const float m_prev = m_st;
      const float m_new = fmaxf(gtot + m_prev, mloc);
      const float a = __expf(gtot + m_prev - m_new);
      const float wl = gtot + e;
      const float rt = -fmaxf(m_prev, pm);
      es[lane] = e;
      rts[lane] = rt;
      isc[lane] = __expf(m_prev + rt);
      emr[lane] = __expf(rt - bc);
      wts[lane] = __expf(wl - m_new);
      wtsb[lane] = f2bf(__expf(wl - m_new));
      if (lane == 0) scal[0] = a;
      m_st = m_new;
    }
    lds_barrier();
#pragma unroll
    for (int i = 0; i < 8; ++i) wvT[(vdq + i) * 72 + vs] = f2bf(wts[vs] * vreg[i]);
    bf16x8 afr[4];
    f32x4 sacc[4];
#pragma unroll
    for (int ni = 0; ni < 4; ++ni) sacc[ni] = f32x4{0.f, 0.f, 0.f, 0.f};
#pragma unroll
    for (int kk = 0; kk < 4; ++kk) {
      afr[kk] = *(const bf16x8*)(qs + (wave * 16 + l15) * 136 + kk * 32 + lq * 8);
#pragma unroll
      for (int ni = 0; ni < 4; ++ni) {
        bf16x8 bb = *(const bf16x8*)(ks_ + (ni * 16 + l15) * 136 + kk * 32 + lq * 8);
        sacc[ni] = mfma16(afr[kk], bb, sacc[ni]);
      }
    }
    float rowsum[4];
#pragma unroll
    for (int jj = 0; jj < 4; ++jj) {
      const int t = wave * 16 + lq * 4 + jj;
      const float rt_t = rts[t];
      float rs = 0.f;
#pragma unroll
      for (int ni = 0; ni < 4; ++ni) {
        const int s = ni * 16 + l15;
        float val = (s <= t) ? sacc[ni][jj] * __expf(rt_t + es[s]) : 0.f;
        rs += val;
        scs[t * 72 + s] = f2bf(val);
      }
      rowsum[jj] = row_sum(rs);
    }
    f32x4 cacc[2];
    cacc[0] = f32x4{0.f, 0.f, 0.f, 0.f};
    cacc[1] = f32x4{0.f, 0.f, 0.f, 0.f};
#pragma unroll
    for (int kk = 0; kk < 4; ++kk) {
#pragma unroll
      for (int dvt = 0; dvt < 2; ++dvt) {
        bf16x8 bb = *(const bf16x8*)(CT + (dvt * 16 + l15) * 136 + kk * 32 + lq * 8);
        cacc[dvt] = mfma16(afr[kk], bb, cacc[dvt]);
      }
    }
    {
      f32x4 qnacc = {0.f, 0.f, 0.f, 0.f};
#pragma unroll
      for (int kk = 0; kk < 4; ++kk) {
        bf16x8 bn = {0, 0, 0, 0, 0, 0, 0, 0};
        if (l15 == 0) bn = *(const bf16x8*)(nT + kk * 32 + lq * 8);
        qnacc = mfma16(afr[kk], bn, qnacc);
      }
      if (l15 == 0) {
#pragma unroll
        for (int jj = 0; jj < 4; ++jj) qn[wave * 16 + lq * 4 + jj] = qnacc[jj];
      }
    }
    lds_barrier();
    {
      f32x4 numa[2];
      numa[0] = f32x4{0.f, 0.f, 0.f, 0.f};
      numa[1] = f32x4{0.f, 0.f, 0.f, 0.f};
#pragma unroll
      for (int kk = 0; kk < 2; ++kk) {
        bf16x8 aa = *(const bf16x8*)(scs + (wave * 16 + l15) * 72 + kk * 32 + lq * 8);
#pragma unroll
        for (int dvt = 0; dvt < 2; ++dvt) {
          bf16x8 bb = *(const bf16x8*)(vT + (dvt * 16 + l15) * 72 + kk * 32 + lq * 8);
          numa[dvt] = mfma16(aa, bb, numa[dvt]);
        }
      }
#pragma unroll
      for (int jj = 0; jj < 4; ++jj) {
        const int t = wave * 16 + lq * 4 + jj;
        const float is = isc[t];
        const float den = rowsum[jj] + is * qn[t];
        const float rden = 1.f / fmaxf(fabsf(den), emr[t]);
#pragma unroll
        for (int dvt = 0; dvt < 2; ++dvt)
          hm[(size_t)(t0 + t) * 1024 + h * 128 + sl * 32 + dvt * 16 + l15] = (numa[dvt][jj] + is * cacc[dvt][jj]) * rden;
      }
    }
    {
      const float a = scal[0];
#pragma unroll
      for (int i = 0; i < 2; ++i) {
        const int sub = wave * 2 + i;
        f32x4 st = stacc[i][0], st1 = stacc[i][1];
        st[0] *= a; st[1] *= a; st[2] *= a; st[3] *= a;
        st1[0] *= a; st1[1] *= a; st1[2] *= a; st1[3] *= a;
        f32x4 na = nacc[i];
        na[0] *= a; na[1] *= a; na[2] *= a; na[3] *= a;
#pragma unroll
        for (int kk = 0; kk < 2; ++kk) {
          bf16x8 aa = *(const bf16x8*)(wvT + l15 * 72 + kk * 32 + lq * 8);
          bf16x8 aa1 = *(const bf16x8*)(wvT + (16 + l15) * 72 + kk * 32 + lq * 8);
          bf16x8 bb;
#pragma unroll
          for (int jj = 0; jj < 8; ++jj) bb[jj] = (short)ks_[(kk * 32 + lq * 8 + jj) * 136 + sub * 16 + l15];
          st = mfma16(aa, bb, st);
          st1 = mfma16(aa1, bb, st1);
          bf16x8 aw = {0, 0, 0, 0, 0, 0, 0, 0};
          if (l15 == 0) aw = *(const bf16x8*)(wtsb + kk * 32 + lq * 8);
          na = mfma16(aw, bb, na);
        }
        stacc[i][0] = st;
        stacc[i][1] = st1;
        nacc[i] = na;
        if (lq == 0) nT[sub * 16 + l15] = f2bf(na[0]);
#pragma unroll
        for (int jj = 0; jj < 4; ++jj) { CT[(lq * 4 + jj) * 136 + sub * 16 + l15] = f2bf(st[jj]); CT[(16 + lq * 4 + jj) * 136 + sub * 16 + l15] = f2bf(st1[jj]); }
      }
    }
    lds_barrier();
  }
}

__device__ void phase2(const Params& P, char* smem) {
  for (int u = blockIdx.x; u < 192; u += P.nblk) {
    if (u < 64) s5_unit(P, u, smem);
    else mlstm_unit(P, u - 64, smem);
  }
  unsigned* ctr = (unsigned*)(P.ws + OFF_TCTR);
  volatile int* s_tile = (volatile int*)(smem + 73728);
  for (;;) {
    __syncthreads();
    if (threadIdx.x == 0) *s_tile = (int)atomicAdd(ctr, 1u);
    __syncthreads();
    const int it = *s_tile;
    if (it >= 3072 + 64) break;
    const int q = it / 3, r = it - q * 3;
    if (it >= 3072) {
      p1_tile<1>(P, smem, it - 3072, 39);
    } else if (r < 2) {
      const int g = 2 * q + r;
      p1_tile<1>(P, smem, g & 63, 40 + (g >> 6));
    } else {
      const size_t off = (size_t)(q & 511) * 65536;
      const float* const* pt = (const float* const*)(P.ws + OFF_TCTR + 64);
      if (q < 512) cvt_fp8_chunk(pt[0] + off, (unsigned char*)(P.ws + OFF_UB) + off, U_SCALE);
      else cvt_fp8_chunk(pt[1] + off, (unsigned char*)(P.ws + OFF_VB) + off, V_SCALE);
    }
  }
}

__device__ void phase3(const Params& P, char* smem) {
  char* ws = P.ws;
  const u16* yg = (const u16*)(ws + OFF_A4);
  const u16* wt = (const u16*)(ws + OFF_WGLU);
  u16* ya = (u16*)(ws + OFF_A1);
  u16* yb = ya + (size_t)T_TOK * 1024;
  const float* hm = (const float*)(ws + OFF_A4 + A4_HM);
  const u16* qkvo = (const u16*)(ws + OFF_A2);
  const int tid = threadIdx.x, lane = tid & 63, wave = tid >> 6, wm = wave >> 1, wn = wave & 1;
  for (int tile = blockIdx.x; tile < 64 * 8; tile += P.nblk) {
    const int mt = tile & 63, nt = tile >> 6;
    const int m0 = mt * 128, n0 = nt * 128;
    f32x4 acc[4][4];
    zero_acc(acc);
    gemm_mainloop(acc, yg + (size_t)m0 * 1024, 1024, wt + (size_t)n0 * 1024, 1024, 1024, smem);
    EPIV_BEGIN
      uint2 yv[4];
      EPIV_INNER
        yv[ni] = *(const uint2*)(yg + (size_t)(m0 + lrow) * 1024 + n0 + lcol0);
      EPIV_INNER_END
      EPIV_MID
      EPIV_INNER
        const f32x4 y = unpack4(yv[ni]);
        const f32x4 bg = *(const f32x4*)((SPF + SP_BGLU) + n0 + lcol0);
        const f32x4 g = sigmoid4(acc[mi][ni] + bg);
        *(uint2*)(ya + (size_t)(m0 + lrow) * 1024 + n0 + lcol0) = pack4(y * g);
      EPIV_INNER_END
    EPIV_END
  }
  for (int t = blockIdx.x * 4 + wave; t < T_TOK; t += P.nblk * 4) {
    const int c0 = (lane >> 3) * 128 + (lane & 7) * 16;
    float v[16], ov[16];
#pragma unroll
    for (int k = 0; k < 4; ++k) {
      const f32x4 a = *(const f32x4*)(hm + (size_t)t * 1024 + c0 + k * 4);
      v[k * 4 + 0] = a[0]; v[k * 4 + 1] = a[1]; v[k * 4 + 2] = a[2]; v[k * 4 + 3] = a[3];
    }
#pragma unroll
    for (int k = 0; k < 2; ++k) {
      const uint4 o = *(const uint4*)(qkvo + (size_t)t * 4096 + 3072 + c0 + k * 8);
      ov[k * 8 + 0] = bflo(o.x); ov[k * 8 + 1] = bfhi(o.x); ov[k * 8 + 2] = bflo(o.y); ov[k * 8 + 3] = bfhi(o.y);
      ov[k * 8 + 4] = bflo(o.z); ov[k * 8 + 5] = bfhi(o.z); ov[k * 8 + 6] = bflo(o.w); ov[k * 8 + 7] = bfhi(o.w);
    }
    float sm = 0.f;
#pragma unroll
    for (int j = 0; j < 16; ++j) sm += v[j];
    sm += dpp_f<0xB1>(sm); sm += dpp_f<0x4E>(sm); sm += dpp_f<0x141>(sm);
    const float mean = sm * (1.f / 128.f);
    float q = 0.f;
#pragma unroll
    for (int j = 0; j < 16; ++j) { v[j] -= mean; q += v[j] * v[j]; }
    q += dpp_f<0xB1>(q); q += dpp_f<0x4E>(q); q += dpp_f<0x141>(q);
    const float rstd = rsqrtf(q * (1.f / 128.f) + 1e-5f);
    float ob[16];
#pragma unroll
    for (int k = 0; k < 4; ++k) {
      const f32x4 wv = *(const f32x4*)(SPF + SP_MHW + c0 + k * 4);
#pragma unroll
      for (int j = 0; j < 4; ++j) ob[k * 4 + j] = ov[k * 4 + j] * v[k * 4 + j] * rstd * wv[j];
    }
    uint4 w0, w1;
    w0.x = pack2(ob[0], ob[1]); w0.y = pack2(ob[2], ob[3]); w0.z = pack2(ob[4], ob[5]); w0.w = pack2(ob[6], ob[7]);
    w1.x = pack2(ob[8], ob[9]); w1.y = pack2(ob[10], ob[11]); w1.z = pack2(ob[12], ob[13]); w1.w = pack2(ob[14], ob[15]);
    *(uint4*)(yb + (size_t)t * 1024 + c0) = w0;
    *(uint4*)(yb + (size_t)t * 1024 + c0 + 8) = w1;
  }
}

__device__ void phase4b(const Params& P, char* smem) {
  char* ws = P.ws;
  const u16* ya = (const u16*)(ws + OFF_A1);
  const u16* yb = ya + (size_t)T_TOK * 1024;
  const u16* w1 = (const u16*)(ws + OFF_WUPS);
  const u16* w2 = (const u16*)(ws + OFF_WUPM);
  const u16* gates = (const u16*)(ws + OFF_A3);
  float* tmpg = (float*)(ws + OFF_A4);
  u16* merged = (u16*)(ws + OFF_A0);
  const int tid = threadIdx.x, lane = tid & 63, wave = tid >> 6, wm = wave >> 1, wn = wave & 1;
  for (int tile = blockIdx.x; tile < 32 * 16; tile += P.nblk) {
    const int mt = tile & 31, nt = tile >> 5;
    const int m0 = mt * 256, n0 = nt * 128;
    f32x4 acc[8][4];
    zero_acc8(acc);
    gemm_mainloop_big(acc, ya + (size_t)m0 * 1024, 1024, w1 + (size_t)n0 * 1024, 1024, 1024, smem);
    EPIV8_BEGIN
      uint2 gv[4];
      EPIV8_INNER
        gv[ni] = *(const uint2*)(gates + (size_t)(m0 + lrow) * 4096 + n0 + lcol0);
      EPIV_INNER_END
      EPIV_MID
      EPIV8_INNER
        *(f32x4*)(tmpg + (size_t)(m0 + lrow) * 2048 + n0 + lcol0) = unpack4(gv[ni]) * acc[mi][ni];
      EPIV_INNER_END
    EPIV_END
    zero_acc8(acc);
    gemm_mainloop_big(acc, yb + (size_t)m0 * 1024, 1024, w2 + (size_t)n0 * 1024, 1024, 1024, smem);
    EPIV8_BEGIN
      uint2 gv[4];
      f32x4 tv[4];
      EPIV8_INNER
        gv[ni] = *(const uint2*)(gates + (size_t)(m0 + lrow) * 4096 + 2048 + n0 + lcol0);
        tv[ni] = *(const f32x4*)(tmpg + (size_t)(m0 + lrow) * 2048 + n0 + lcol0);
      EPIV_INNER_END
      EPIV_MID
      EPIV8_INNER
        *(uint2*)(merged + (size_t)(m0 + lrow) * 2048 + n0 + lcol0) = pack4(tv[ni] + unpack4(gv[ni]) * acc[mi][ni]);
      EPIV_INNER_END
    EPIV_END
  }
}

__device__ void phase5(const Params& P, char* smem) {
  char* ws = P.ws;
  const u16* merged = (const u16*)(ws + OFF_A0);
  const u16* wt = (const u16*)(ws + OFF_WOUT);
  float* r1 = (float*)(ws + OFF_A2);
  const int tid = threadIdx.x, lane = tid & 63, wave = tid >> 6, wm = wave >> 1, wn = wave & 1;
  for (int tile = blockIdx.x; tile < 32 * 16; tile += P.nblk) {
    const int mt = tile & 31, nt = tile >> 5;
    const int m0 = mt * 256, n0 = nt * 128;
    f32x4 acc[8][4];
    zero_acc8(acc);
    gemm_mainloop_big(acc, merged + (size_t)m0 * 2048, 2048, wt + (size_t)n0 * 2048, 2048, 2048, smem);
    EPIV8_BEGIN
      f32x4 xv[4];
      EPIV8_INNER
        xv[ni] = *(const f32x4*)(P.x + (size_t)(m0 + lrow) * 2048 + n0 + lcol0);
      EPIV_INNER_END
      EPIV_MID
      EPIV8_INNER
        *(f32x4*)(r1 + (size_t)(m0 + lrow) * 2048 + n0 + lcol0) = xv[ni] * DN_ALPHA + acc[mi][ni];
      EPIV_INNER_END
    EPIV_END
  }
}

__device__ void phase6(const Params& P, char* smem) {
  char* ws = P.ws;
  float* r1 = (float*)(ws + OFF_A2);
  u16* h1b = (u16*)(ws + OFF_A0);
  const int tid = threadIdx.x, lane = tid & 63, wave = tid >> 6;
  for (int r = blockIdx.x * 4 + wave; r < T_TOK; r += P.nblk * 4) {
    float* row = r1 + (size_t)r * 2048;
    float v[32];
    float s = 0.f;
#pragma unroll
    for (int i = 0; i < 4; ++i) {
      float4 a = *(const float4*)(row + i * 512 + lane * 8);
      float4 c = *(const float4*)(row + i * 512 + lane * 8 + 4);
      v[i * 8 + 0] = a.x; v[i * 8 + 1] = a.y; v[i * 8 + 2] = a.z; v[i * 8 + 3] = a.w;
      v[i * 8 + 4] = c.x; v[i * 8 + 5] = c.y; v[i * 8 + 6] = c.z; v[i * 8 + 7] = c.w;
    }
#pragma unroll
    for (int i = 0; i < 32; ++i) s += v[i];
    const float mean = wave_sum(s) * (1.f / 2048.f);
    float q = 0.f;
#pragma unroll
    for (int i = 0; i < 32; ++i) { v[i] -= mean; q += v[i] * v[i]; }
    const float rstd = rsqrtf(wave_sum(q) * (1.f / 2048.f) + 1e-5f);
#pragma unroll
    for (int i = 0; i < 4; ++i) {
      const int c0 = i * 512 + lane * 8;
      float o[8];
#pragma unroll
      for (int jj = 0; jj < 8; ++jj) o[jj] = v[i * 8 + jj] * rstd * (SPF + SP_LN1G)[c0 + jj] + (SPF + SP_LN1B)[c0 + jj];
      *(float4*)(row + c0) = float4{o[0], o[1], o[2], o[3]};
      *(float4*)(row + c0 + 4) = float4{o[4], o[5], o[6], o[7]};
      uint4 w;
      w.x = pack2(o[0], o[1]); w.y = pack2(o[2], o[3]); w.z = pack2(o[4], o[5]); w.w = pack2(o[6], o[7]);
      *(uint4*)(h1b + (size_t)r * 2048 + c0) = w;
    }
  }
}

__device__ void phase7(const Params& P, char* smem) {
  char* ws = P.ws;
  const u16* h1b = (const u16*)(ws + OFF_A0);
  const u16* wt = (const u16*)(ws + OFF_WQ);
  const u16* keysb = (const u16*)(ws + OFF_KEYS);
  float* tops = (float*)(ws + OFF_A4);
  int* topi = (int*)(ws + OFF_A4 + A4_TOPI);
  const int tid = threadIdx.x, lane = tid & 63, wave = tid >> 6, wm = wave >> 1, wn = wave & 1;
  for (int tile = blockIdx.x; tile < 64 * 16; tile += P.nblk) {
    const int mt = tile & 63, nt = tile >> 6;
    const int m0 = mt * 128, n0 = nt * 128;
    f32x4 acc[4][4];
    zero_acc(acc);
    gemm_mainloop(acc, h1b + (size_t)m0 * 2048, 2048, wt + (size_t)n0 * 2048, 2048, 2048, smem);
    u16* Q = (u16*)smem;
    u16* Kt = Q + 128 * 136;
    EPIV_BEGIN EPIV_INNER
      *(uint2*)(Q + lrow * 136 + lcol0) = pack4(acc[mi][ni]);
    EPIV_INNER_END EPIV_END
    {
      const u16* kb = keysb + (size_t)nt * 128 * 128;
#pragma unroll 4
      for (int i = 0; i < 8; ++i) {
        const int id = tid + i * 256;
        const int row = id >> 4, ch = id & 15;
        *(uint4*)(Kt + row * 136 + ch * 8) = *(const uint4*)(kb + row * 128 + ch * 8);
      }
    }
    __syncthreads();
    zero_acc(acc);
#pragma unroll
    for (int ks = 0; ks < 4; ++ks) {
      bf16x8 af[4], bfr[4];
#pragma unroll
      for (int mi = 0; mi < 4; ++mi)
        af[mi] = *(const bf16x8*)(Q + (wm * 64 + mi * 16 + (lane & 15)) * 136 + ks * 32 + (lane >> 4) * 8);
#pragma unroll
      for (int ni = 0; ni < 4; ++ni)
        bfr[ni] = *(const bf16x8*)(Kt + (wn * 64 + ni * 16 + (lane & 15)) * 136 + ks * 32 + (lane >> 4) * 8);
#pragma unroll
      for (int mi = 0; mi < 4; ++mi)
#pragma unroll
        for (int ni = 0; ni < 4; ++ni) acc[mi][ni] = mfma16(bfr[ni], af[mi], acc[mi][ni]);
    }
    __syncthreads();
    float* Sc = (float*)smem;
    EPIV_BEGIN EPIV_INNER
      *(f32x4*)(Sc + lrow * 132 + lcol0) = acc[mi][ni];
    EPIV_INNER_END EPIV_END
    __syncthreads();
    {
      const int row = tid >> 1, half = tid & 1;
      float* r = Sc + row * 132 + half * 64;
      const size_t ob = ((size_t)(m0 + row) * 16 + nt) * 16;
      for (int k = 0; k < 16; ++k) {
        float best = -3.0e38f;
        int bi = 0;
#pragma unroll 4
        for (int c4 = 0; c4 < 16; ++c4) {
          const f32x4 v4 = *(const f32x4*)(r + c4 * 4);
#pragma unroll
          for (int j = 0; j < 4; ++j)
            if (v4[j] > best) { best = v4[j]; bi = c4 * 4 + j; }
        }
        const float obest = dpp_f<0xB1>(best);
        const int obi = __builtin_amdgcn_update_dpp(0, bi, 0xB1, 0xF, 0xF, false);
        const int mycol = half * 64 + bi, ocol = (half ^ 1) * 64 + obi;
        const bool mine = (best > obest) || (best == obest && mycol < ocol);
        if (half == 0) {
          tops[ob + k] = mine ? best : obest;
          topi[ob + k] = mine ? mycol : ocol;
        }
        if (mine) r[bi] = -3.0e38f;
      }
    }
    __syncthreads();
  }
}

__device__ void phase9(const Params& P, char* smem) {
  char* ws = P.ws;
  const float* h1 = (const float*)(ws + OFF_A2);
  const float* tops = (const float*)(ws + OFF_A4);
  const int* topi = (const int*)(ws + OFF_A4 + A4_TOPI);
  const unsigned char* Ub = (const unsigned char*)(ws + OFF_UB);
  const unsigned char* Vb = (const unsigned char*)(ws + OFF_VB);
  float* h2 = (float*)(ws + OFF_A3);
  u16* h2b = (u16*)(ws + OFF_A4 + A4_H2B);
  const int tid = threadIdx.x, lane = tid & 63, wave = tid >> 6;
  int ca, cb;
  {
    const int l = lane;
    if (l < 16) { ca = 0; cb = l; }
    else if (l < 24) { ca = 1; cb = l - 16; }
    else if (l < 29) { ca = 2; cb = l - 24; }
    else if (l < 33) { ca = 3; cb = l - 29; }
    else if (l < 36) { ca = 4; cb = l - 33; }
    else if (l < 38) { ca = 5; cb = l - 36; }
    else if (l < 40) { ca = 6; cb = l - 38; }
    else if (l < 42) { ca = 7; cb = l - 40; }
    else if (l < 50) { ca = l - 34; cb = 0; }
    else { ca = 0; cb = 0; }
  }
  const bool cvalid = lane < 50;
  f32x4* xs = (f32x4*)(smem + wave * 8192);
  const __amdgpu_buffer_rsrc_t rsU = __builtin_amdgcn_make_buffer_rsrc((void*)Ub, 0, 0x7fffffff, 0x00020000);
  const __amdgpu_buffer_rsrc_t rsV = __builtin_amdgcn_make_buffer_rsrc((void*)Vb, 0, 0x7fffffff, 0x00020000);
  for (int t = blockIdx.x * 4 + wave; t < T_TOK; t += P.nblk * 4) {
    {
      const float* row = h1 + (size_t)t * 2048;
#pragma unroll
      for (int i = 0; i < 2; ++i)
#pragma unroll
        for (int k = 0; k < 4; ++k) xs[(i * 4 + k) * 64 + lane] = *(const f32x4*)(row + i * 1024 + lane * 16 + k * 4);
    }
    float sc0 = 0.f, sc1 = 0.f;
    int id0 = 0, id1 = 0;
#pragma unroll
    for (int hs = 0; hs < 2; ++hs) {
#pragma unroll 1
      for (int hq = 0; hq < 4; ++hq) {
        const int head = hs * 4 + hq;
        const size_t ob = ((size_t)t * 16 + head * 2) * 16;
        float val = -3.0e38f;
        int eid = 0;
        if (cvalid) {
          val = tops[ob + ca] + tops[ob + 16 + cb];
          eid = topi[ob + ca] * 128 + topi[ob + 16 + cb];
        }
#pragma unroll 1
        for (int k = 0; k < 16; ++k) {
          const float m = wave_max(val);
          const unsigned long long mask = __ballot(val == m);
          const int win = __ffsll((long long)mask) - 1;
          const int widx = __builtin_amdgcn_readlane(eid, win);
          if (lane == hq * 16 + k) {
            if (hs == 0) { sc0 = m; id0 = widx; } else { sc1 = m; id1 = widx; }
          }
          if (lane == win) val = -3.0e38f;
        }
      }
    }
    float g0, g1;
    {
      const float mx0 = row_max(sc0), mx1 = row_max(sc1);
      const float e0 = __expf(sc0 - mx0), e1 = __expf(sc1 - mx1);
      const float s0 = row_sum(e0), s1 = row_sum(e1);
      g0 = e0 / s0; g1 = e1 / s1;
    }
    float acc[32];
#pragma unroll
    for (int i = 0; i < 32; ++i) acc[i] = 0.f;
    u32x4v U00, U01, U10, U11, U20, U21, U30, U31, V00, V01, V10, V11, V20, V21, V30, V31;
#define P9_LDU(S, idv) { const int so_ = (idv) * 2048; U##S##0 = __builtin_amdgcn_raw_buffer_load_b128(rsU, lane * 16, so_, 0); U##S##1 = __builtin_amdgcn_raw_buffer_load_b128(rsU, lane * 16 + 1024, so_, 0); }
#define P9_LDV(S, idv) { const int so_ = (idv) * 2048; V##S##0 = __builtin_amdgcn_raw_buffer_load_b128(rsV, lane * 16, so_, 0); V##S##1 = __builtin_amdgcn_raw_buffer_load_b128(rsV, lane * 16 + 1024, so_, 0); }
#define P9_DOT8(W, XB, sacc) {                                                         \
      _Pragma("unroll") for (int k = 0; k < 4; ++k) {                                  \
        const f32x2 lo = __builtin_amdgcn_cvt_pk_f32_fp8((int)(W)[k], false);          \
        const f32x2 hi = __builtin_amdgcn_cvt_pk_f32_fp8((int)(W)[k], true);           \
        const f32x4 xv = xs[((XB) + k) * 64 + lane];                                   \
        sacc##A = f32x2{xv[0], xv[1]} * lo + sacc##A;                                  \
        sacc##B = f32x2{xv[2], xv[3]} * hi + sacc##B;                                  \
      } }
#define P9_AXPY8(W, AB, a_) {                                                          \
      _Pragma("unroll") for (int k = 0; k < 4; ++k) {                                  \
        const f32x2 lo = __builtin_amdgcn_cvt_pk_f32_fp8((int)(W)[k], false);          \
        const f32x2 hi = __builtin_amdgcn_cvt_pk_f32_fp8((int)(W)[k], true);           \
        acc[(AB) + k * 4 + 0] += a_ * lo[0]; acc[(AB) + k * 4 + 1] += a_ * lo[1];      \
        acc[(AB) + k * 4 + 2] += a_ * hi[0]; acc[(AB) + k * 4 + 3] += a_ * hi[1];      \
      } }
#define P9_STEP(S, e_) {                                                               \
      const int e = (e_);                                                              \
      f32x2 d_A = {0.f, 0.f}, d_B = {0.f, 0.f};                                        \
      P9_DOT8(U##S##0, 0, d_)                                                          \
      P9_DOT8(U##S##1, 4, d_)                                                          \
      float d_ = (d_A[0] + d_A[1]) + (d_B[0] + d_B[1]);                                \
      const float gt_ = (e < 64) ? rdl(g0, e & 63) : rdl(g1, e & 63);                  \
      const int en_ = (e + 4) & 127;                                                   \
      const int idn_ = (en_ < 64) ? __builtin_amdgcn_readlane(id0, en_ & 63) : __builtin_amdgcn_readlane(id1, en_ & 63); \
      __builtin_amdgcn_sched_barrier(0);                                               \
      P9_LDU(S, idn_)                                                                  \
      __builtin_amdgcn_sched_barrier(0);                                               \
      d_ = wave_sum(d_);                                                               \
      const float a_ = gelu_tanh(d_ * (1.f / U_SCALE)) * gt_ * (1.f / V_SCALE);        \
      P9_AXPY8(V##S##0, 0, a_)                                                         \
      P9_AXPY8(V##S##1, 16, a_)                                                        \
      __builtin_amdgcn_sched_barrier(0);                                               \
      P9_LDV(S, idn_)                                                                  \
      __builtin_amdgcn_sched_barrier(0);                                               \
    }
    {
      const int i0_ = __builtin_amdgcn_readlane(id0, 0), i1_ = __builtin_amdgcn_readlane(id0, 1), i2_ = __builtin_amdgcn_readlane(id0, 2), i3_ = __builtin_amdgcn_readlane(id0, 3);
      P9_LDU(0, i0_) P9_LDV(0, i0_) P9_LDU(1, i1_) P9_LDV(1, i1_) P9_LDU(2, i2_) P9_LDV(2, i2_) P9_LDU(3, i3_) P9_LDV(3, i3_)
    }
#pragma unroll 1
    for (int eb = 0; eb < 128; eb += 4) {
      P9_STEP(0, eb)
      P9_STEP(1, eb + 1)
      P9_STEP(2, eb + 2)
      P9_STEP(3, eb + 3)
    }
#undef P9_LDU
#undef P9_LDV
#undef P9_DOT8
#undef P9_AXPY8
#undef P9_STEP
    float s = 0.f;
#pragma unroll
    for (int jq = 0; jq < 8; ++jq) {
      const f32x4 xv = xs[jq * 64 + lane];
#pragma unroll
      for (int c = 0; c < 4; ++c) { acc[jq * 4 + c] = DN_ALPHA * xv[c] + acc[jq * 4 + c]; s += acc[jq * 4 + c]; }
    }
    const float mean = wave_sum(s) * (1.f / 2048.f);
    float qv = 0.f;
#pragma unroll
    for (int i = 0; i < 32; ++i) { acc[i] -= mean; qv += acc[i] * acc[i]; }
    const float rstd = rsqrtf(wave_sum(qv) * (1.f / 2048.f) + 1e-5f);
    const int lz9 = lane + opaque0();
#pragma unroll
    for (int i = 0; i < 2; ++i) {
      const int c0 = i * 1024 + lz9 * 16;
      float o[16];
#pragma unroll
      for (int k = 0; k < 4; ++k) {
        const f32x4 gg = *(const f32x4*)(SPF + SP_LN2G + c0 + k * 4);
        const f32x4 bb = *(const f32x4*)(SPF + SP_LN2B + c0 + k * 4);
#pragma unroll
        for (int j = 0; j < 4; ++j) o[k * 4 + j] = acc[i * 16 + k * 4 + j] * rstd * gg[j] + bb[j];
        *(float4*)(h2 + (size_t)t * 2048 + c0 + k * 4) = float4{o[k * 4], o[k * 4 + 1], o[k * 4 + 2], o[k * 4 + 3]};
      }
      uint4 w0, w1;
      w0.x = pack2(o[0], o[1]); w0.y = pack2(o[2], o[3]); w0.z = pack2(o[4], o[5]); w0.w = pack2(o[6], o[7]);
      w1.x = pack2(o[8], o[9]); w1.y = pack2(o[10], o[11]); w1.z = pack2(o[12], o[13]); w1.w = pack2(o[14], o[15]);
      *(uint4*)(h2b + (size_t)t * 2048 + c0) = w0;
      *(uint4*)(h2b + (size_t)t * 2048 + c0 + 8) = w1;
    }
  }
}

__device__ void phase10(const Params& P, char* smem) {
  char* ws = P.ws;
  const u16* h2b = (const u16*)(ws + OFF_A4 + A4_H2B);
  const float* h2 = (const float*)(ws + OFF_A3);
  const u16* pb = (const u16*)(ws + OFF_PB);
  const u16* wg = (const u16*)(ws + OFF_WPG);
  const u16* wp = (const u16*)(ws + OFF_WPP);
  float* ppb = (float*)(ws + OFF_A2);
  const int tid = threadIdx.x, lane = tid & 63, wave = tid >> 6, wm = wave >> 1, wn = wave & 1;
  for (int tile = blockIdx.x; tile < 32 * 16; tile += P.nblk) {
    const int mt = tile & 31, nt = tile >> 5;
    const int m0 = mt * 256, n0 = nt * 128;
    f32x4 acc[8][4];
    zero_acc8(acc);
    gemm_mainloop_big(acc, pb + (size_t)m0 * 256, 256, wp + (size_t)n0 * 256, 256, 256, smem);
    EPIV8_BEGIN EPIV8_INNER
      *(f32x4*)(ppb + (size_t)(m0 + lrow) * 2048 + n0 + lcol0) = acc[mi][ni];
    EPIV_INNER_END EPIV_END
    zero_acc8(acc);
    gemm_mainloop_big(acc, h2b + (size_t)m0 * 2048, 2048, wg + (size_t)n0 * 2048, 2048, 2048, smem);
    EPIV8_BEGIN
      f32x4 hv[4], pv[4];
      EPIV8_INNER
        hv[ni] = *(const f32x4*)(h2 + (size_t)(m0 + lrow) * 2048 + n0 + lcol0);
        pv[ni] = *(const f32x4*)(ppb + (size_t)(m0 + lrow) * 2048 + n0 + lcol0);
      EPIV_INNER_END
      EPIV_MID
      EPIV8_INNER
        *(f32x4*)(P.out + (size_t)(m0 + lrow) * 2048 + n0 + lcol0) = hv[ni] + sigmoid4(acc[mi][ni]) * pv[ni];
      EPIV_INNER_END
    EPIV_END
  }
}

constexpr int N_PHASES = 11;


#define XB_TMO      128
#define XB_XCNT(j)  (256  + 64 * (j))
#define XB_XSUB(j)  (1280 + 64 * (j))
#define XB_XGEN(j)  (2304 + 64 * (j))
#define XB_TOP      3328
#define XB_TOPGEN   3392
#define XCD_BAR_WORDS 3456
#define XB_SPIN_CAP (1u << 18)
#define LAS __attribute__((address_space(3)))
__device__ __forceinline__ unsigned xb_ld(unsigned* p)              { return __hip_atomic_load(p, __ATOMIC_RELAXED, __HIP_MEMORY_SCOPE_AGENT); }
__device__ __forceinline__ unsigned xb_add(unsigned* p, unsigned v) { return __hip_atomic_fetch_add(p, v, __ATOMIC_RELAXED, __HIP_MEMORY_SCOPE_AGENT); }
__device__ __forceinline__ unsigned xb_xcc_id() { return (unsigned)__builtin_amdgcn_s_getreg((3 << 11) | 20) & 0xFu; }
#define XB_SPIN(cond, bar) do { unsigned _sp = 0; while (cond) { __builtin_amdgcn_s_sleep(1); \
    if ((++_sp & 255u) == 0u) { if (xb_ld(&(bar)[XB_TMO])) break; if (_sp > XB_SPIN_CAP) { atomicAdd(&(bar)[XB_TMO], 1u); break; } } } } while (0)
struct XcdBarrier { unsigned* bar; unsigned x; volatile LAS unsigned* st; unsigned grid; };
__device__ __forceinline__ XcdBarrier xcd_barrier_post(unsigned* bar, volatile LAS unsigned* st) {
  XcdBarrier b; b.bar = bar; b.x = xb_xcc_id(); b.st = st; b.grid = 0u;
  if (threadIdx.x == 0) (void)xb_add(&bar[XB_XCNT(b.x)], 1u);
  return b;
}
__device__ __forceinline__ void xcd_barrier_complete(unsigned* bar, unsigned x, unsigned& nloc, unsigned& nx, const unsigned xb_grid) {
  const unsigned G = xb_grid;
  unsigned sum, cnt, mine, sp = 0u;
  for (;;) {
    sum = 0u; cnt = 0u; mine = 0u;
#pragma unroll
    for (unsigned j = 0; j < 16; ++j) { const unsigned c = xb_ld(&bar[XB_XCNT(j)]); sum += c; cnt += (c > 0u) ? 1u : 0u; mine = (j == x) ? c : mine; }
    if (sum == G) break;
    __builtin_amdgcn_s_sleep(1);
    if ((++sp & 255u) == 0u) { if (xb_ld(&bar[XB_TMO])) break; if (sp > XB_SPIN_CAP) { atomicAdd(&bar[XB_TMO], 1u); break; } }
  }
  nloc = mine > 0u ? mine : 1u; nx = cnt > 0u ? cnt : 1u;
}
__device__ __forceinline__ void xcd_barrier(const XcdBarrier& b) {
  asm volatile("s_waitcnt vmcnt(0)" ::: "memory");
  __syncthreads();
  if (threadIdx.x == 0) {
    unsigned* bar = b.bar;
    __builtin_amdgcn_s_waitcnt(0);
    unsigned nloc = b.st[0], nx = b.st[1];
    if (nloc == 0u) { xcd_barrier_complete(bar, b.x, nloc, nx, b.grid); b.st[0] = nloc; b.st[1] = nx; }
    const unsigned old = xb_add(&bar[XB_XSUB(b.x)], 1u);
    const unsigned gen = old / nloc;
    if (old + 1u == (gen + 1u) * nloc) {
      __builtin_amdgcn_fence(__ATOMIC_RELEASE, "agent");
      asm volatile("s_waitcnt vmcnt(0)" ::: "memory");
      const unsigned og = xb_add(&bar[XB_TOP], 1u);
      const unsigned tg = og / nx;
      if (og + 1u == (tg + 1u) * nx) xb_add(&bar[XB_TOPGEN], 1u);
      else XB_SPIN(xb_ld(&bar[XB_TOPGEN]) == tg, bar);
      __builtin_amdgcn_fence(__ATOMIC_ACQUIRE, "agent");
      xb_add(&bar[XB_XGEN(b.x)], 1u);
      asm volatile("s_waitcnt vmcnt(0)" ::: "memory");
    } else {
      XB_SPIN(xb_ld(&bar[XB_XGEN(b.x)]) == gen, bar);
      __builtin_amdgcn_fence(__ATOMIC_ACQUIRE, "agent");
      asm volatile("s_waitcnt vmcnt(0)" ::: "memory");
    }
  }
  __syncthreads();
}

template <int MODE>
__global__ void __launch_bounds__(256, 2) mega(Params P) {
  __shared__ __attribute__((aligned(16))) char smem[SMEM_BYTES];
  __shared__ uint4 xb_words;
  if (MODE < 0) {
    if (threadIdx.x == 0) xb_words = make_uint4(0u, 0u, 0u, 0u);
    __syncthreads();
    (void)xcd_barrier_post((unsigned*)(P.ws + OFF_BAR), (volatile LAS unsigned*)&xb_words);
  }
#define XB_HERE() XcdBarrier{(unsigned*)(P.ws + OFF_BAR), xb_xcc_id(), (volatile LAS unsigned*)&xb_words, (unsigned)P.nblk}
#define RUN_PHASE(n, fn)                                              \
  if (MODE < 0 || MODE == n) {                                        \
    fn(P, smem);                                                      \
    if (MODE < 0 && n + 1 < N_PHASES) {                               \
      if (P.ws == nullptr) cg::this_grid().sync(); else xcd_barrier(XB_HERE()); \
    }                                                                 \
  }
  RUN_PHASE(0, phase0)
  RUN_PHASE(1, phase1)
  RUN_PHASE(2, phase1c)
  RUN_PHASE(3, phase2)
  RUN_PHASE(4, phase3)
  RUN_PHASE(5, phase4b)
  RUN_PHASE(6, phase5)
  RUN_PHASE(7, phase6)
  RUN_PHASE(8, phase7)
  RUN_PHASE(9, phase9)
  RUN_PHASE(10, phase10)
}

template <int PH>
static void launch_phase(Params P, hipStream_t stream) {
  P.nblk = 512;
  hipLaunchKernelGGL(mega<PH>, dim3(512), dim3(256), 0, stream, P);
}

extern "C" void kernel_launch(void* const* d_in, const int* in_sizes, int n_in, void* d_out, int out_size,
                              void* d_ws, size_t ws_size, hipStream_t stream) {
  Params P{};
  const float** pp = (const float**)&P;
  for (int i = 0; i < 30; ++i) pp[i] = (const float*)d_in[i];
  P.out = (float*)d_out;
  P.ws = (char*)d_ws;
  if (ws_size < OFF_END2) {
    fprintf(stderr, "workspace too small: %zu < %zu\n", ws_size, (size_t)OFF_END2);
    return;
  }
#if COOP_LAUNCH
  static int grid_blocks = 0;
  if (!grid_blocks) {
    int dev = 0, cus = 0, per_cu = 0;
    hipGetDevice(&dev);
    hipDeviceGetAttribute(&cus, hipDeviceAttributeMultiprocessorCount, dev);
    hipOccupancyMaxActiveBlocksPerMultiprocessor(&per_cu, mega<-1>, 256, 0);
    grid_blocks = cus * per_cu;
  }
  hipMemsetAsync((char*)d_ws + OFF_BAR, 0, XCD_BAR_WORDS * 4 + 256, stream);
  P.nblk = grid_blocks;
  void* args[] = {&P};
  hipError_t e = hipLaunchCooperativeKernel((void*)mega<-1>, dim3(grid_blocks), dim3(256), args, 0, stream);
  if (e != hipSuccess) fprintf(stderr, "cooperative launch failed: %s (grid %d)\n", hipGetErrorString(e), grid_blocks);
#else
  launch_phase<0>(P, stream);
  launch_phase<1>(P, stream);
  launch_phase<2>(P, stream);
  launch_phase<3>(P, stream);
  launch_phase<4>(P, stream);
  launch_phase<5>(P, stream);
  launch_phase<6>(P, stream);
  launch_phase<7>(P, stream);
  launch_phase<8>(P, stream);
  launch_phase<9>(P, stream);
  launch_phase<10>(P, stream);
#endif
}
```

```cpp
#include <hip/hip_runtime.h>
#include <hip/hip_bf16.h>
#include <hip/hip_cooperative_groups.h>
#include <cstdio>
namespace cg = cooperative_groups;

typedef unsigned short u16;
using bf16x8 = __attribute__((ext_vector_type(8))) short;
using f32x4 = __attribute__((ext_vector_type(4))) float;
using f32x2 = __attribute__((ext_vector_type(2))) float;
typedef unsigned u32x4v __attribute__((ext_vector_type(4)));

#ifndef COOP_LAUNCH
#define COOP_LAUNCH 1
#endif

constexpr int T_TOK = 8192;
constexpr int DM = 2048;
constexpr int NWIN = 9344;
constexpr float DN_ALPHA = 1.189207115002721f;
constexpr int SMEM_BYTES = 73728 + 16;
constexpr float U_SCALE = 512.f, V_SCALE = 64.f;

constexpr size_t OFF_WIN  = 0;
constexpr size_t OFF_WGLU = OFF_WIN  + (size_t)NWIN * 2048 * 2;
constexpr size_t OFF_WUPS = OFF_WGLU + (size_t)1024 * 1024 * 2;
constexpr size_t OFF_WUPM = OFF_WUPS + (size_t)2048 * 1024 * 2;
constexpr size_t OFF_WOUT = OFF_WUPM + (size_t)2048 * 1024 * 2;
constexpr size_t OFF_WQ   = OFF_WOUT + (size_t)2048 * 2048 * 2;
constexpr size_t OFF_WPG  = OFF_WQ   + (size_t)2048 * 2048 * 2;
constexpr size_t OFF_WPP  = OFF_WPG  + (size_t)2048 * 2048 * 2;
constexpr size_t OFF_KEYS = OFF_WPP  + (size_t)2048 * 256 * 2;
constexpr size_t OFF_UB   = OFF_KEYS + (size_t)8 * 2 * 128 * 128 * 2;
constexpr size_t OFF_VB   = OFF_UB   + (size_t)16384 * 2048 * 2;
constexpr size_t OFF_S5P  = OFF_VB   + (size_t)16384 * 2048 * 2;
constexpr size_t OFF_PB   = OFF_S5P  + (size_t)(4096 * 2 + 65536 * 2) * 4;
constexpr size_t OFF_IF   = OFF_PB   + (size_t)T_TOK * 256 * 2;
constexpr size_t OFF_A0   = OFF_IF   + (size_t)T_TOK * 16 * 4;
constexpr size_t OFF_A1   = OFF_A0   + (size_t)T_TOK * 2048 * 2;
constexpr size_t OFF_A2   = OFF_A1   + (size_t)T_TOK * 1024 * 4;
constexpr size_t OFF_A3   = OFF_A2   + (size_t)T_TOK * 4096 * 2;
constexpr size_t OFF_A4   = OFF_A3   + (size_t)T_TOK * 4096 * 2;
constexpr size_t OFF_END  = OFF_A4   + (size_t)T_TOK * 4096 * 2;
constexpr size_t OFF_SP   = OFF_END;
constexpr int SP_BIG = 0, SP_BFG = 8, SP_CONV = 16, SP_MHW = SP_CONV + 8192, SP_CRE = SP_MHW + 1024, SP_CIM = SP_CRE + 65536,
              SP_SSMD = SP_CIM + 65536, SP_BGLU = SP_SSMD + 1024, SP_LN1G = SP_BGLU + 1024, SP_LN1B = SP_LN1G + 2048,
              SP_LN2G = SP_LN1B + 2048, SP_LN2B = SP_LN2G + 2048, SP_TOTAL = SP_LN2B + 2048;
constexpr size_t OFF_BAR  = ((OFF_SP + (size_t)SP_TOTAL * 4 + 255) / 256) * 256;
constexpr size_t OFF_TCTR = OFF_BAR + 3456 * 4;
constexpr size_t OFF_QKC  = OFF_TCTR + 256;
constexpr size_t OFF_END2 = OFF_QKC + (size_t)T_TOK * 2048 * 2;
constexpr size_t A4_HM    = (size_t)T_TOK * 1024 * 2;
constexpr size_t A4_TOPI  = (size_t)T_TOK * 256 * 4;
constexpr size_t A4_H2B   = (size_t)T_TOK * 1024 * 2;

struct Params {
  const float *x, *p, *w_in, *b_ig, *b_fg, *conv_qk, *mh_norm_w, *a_re, *a_im, *log_dt, *b_re, *b_im,
      *c_re, *c_im, *ssm_d, *w_glu, *b_glu, *w_up_ssm, *w_up_ml, *w_out, *ln1_g, *ln1_b, *peer_wq,
      *peer_keys, *peer_u, *peer_v, *ln2_g, *ln2_b, *ple_wg, *ple_wp;
  float* out;
  char* ws;
  int nblk;
  int pad_;
};

typedef __bf16 bf16x2_t __attribute__((ext_vector_type(2)));
__device__ __forceinline__ unsigned pack2(float a, float b) {
  const f32x2 v = {a, b};
  return __builtin_bit_cast(unsigned, __builtin_convertvector(v, bf16x2_t));
}
__device__ __forceinline__ u16 f2bf(float f) { return (u16)(pack2(f, 0.f) & 0xffffu); }
__device__ __forceinline__ float bf2f(u16 h) { return __uint_as_float(((unsigned)h) << 16); }
__device__ __forceinline__ float bflo(unsigned u) { return __uint_as_float(u << 16); }
__device__ __forceinline__ float bfhi(unsigned u) { return __uint_as_float(u & 0xffff0000u); }
__device__ __forceinline__ float sigmoidf_(float x) { return __builtin_amdgcn_rcpf(1.f + __expf(-x)); }
__device__ __forceinline__ float gelu_tanh(float x) {
  float u = 0.7978845608028654f * (x + 0.044715f * x * x * x);
  float t = 1.f - 2.f * __builtin_amdgcn_rcpf(1.f + __expf(2.f * u));
  return 0.5f * x * (1.f + t);
}
template <int CTRL> __device__ __forceinline__ float dpp_f(float v) {
  return __builtin_bit_cast(float, __builtin_amdgcn_update_dpp(0, __builtin_bit_cast(int, v), CTRL, 0xF, 0xF, false));
}
__device__ __forceinline__ float rdl(float v, int l) { return __builtin_bit_cast(float, __builtin_amdgcn_readlane(__builtin_bit_cast(int, v), l)); }
__device__ __forceinline__ float row_sum(float v) {
  v += dpp_f<0xB1>(v); v += dpp_f<0x4E>(v); v += dpp_f<0x141>(v); v += dpp_f<0x140>(v);
  return v;
}
__device__ __forceinline__ float row_max(float v) {
  v = fmaxf(v, dpp_f<0xB1>(v)); v = fmaxf(v, dpp_f<0x4E>(v)); v = fmaxf(v, dpp_f<0x141>(v)); v = fmaxf(v, dpp_f<0x140>(v));
  return v;
}
template <int CTRL, int ROWMASK> __device__ __forceinline__ float dpp_fm(float old, float v) {
  return __builtin_bit_cast(float, __builtin_amdgcn_update_dpp(__builtin_bit_cast(int, old), __builtin_bit_cast(int, v), CTRL, ROWMASK, 0xF, false));
}
__device__ __forceinline__ float wave_scan_sum(float v) {
  v += dpp_fm<0x111, 0xF>(0.f, v);
  v += dpp_fm<0x112, 0xF>(0.f, v);
  v += dpp_fm<0x114, 0xF>(0.f, v);
  v += dpp_fm<0x118, 0xF>(0.f, v);
  v += dpp_fm<0x142, 0xA>(0.f, v);
  v += dpp_fm<0x143, 0xC>(0.f, v);
  return v;
}
__device__ __forceinline__ float wave_scan_max(float v) {
  const float ninf = -3.0e38f;
  v = fmaxf(v, dpp_fm<0x111, 0xF>(ninf, v));
  v = fmaxf(v, dpp_fm<0x112, 0xF>(ninf, v));
  v = fmaxf(v, dpp_fm<0x114, 0xF>(ninf, v));
  v = fmaxf(v, dpp_fm<0x118, 0xF>(ninf, v));
  v = fmaxf(v, dpp_fm<0x142, 0xA>(ninf, v));
  v = fmaxf(v, dpp_fm<0x143, 0xC>(ninf, v));
  return v;
}
__device__ __forceinline__ float wave_sum(float v) {
  v = row_sum(v);
  return (rdl(v, 0) + rdl(v, 16)) + (rdl(v, 32) + rdl(v, 48));
}
__device__ __forceinline__ float wave_max(float v) {
  v = row_max(v);
  return fmaxf(fmaxf(rdl(v, 0), rdl(v, 16)), fmaxf(rdl(v, 32), rdl(v, 48)));
}
__device__ __forceinline__ f32x4 mfma16(bf16x8 a, bf16x8 b, f32x4 c) {
  return __builtin_amdgcn_mfma_f32_16x16x32_bf16(a, b, c, 0, 0, 0);
}

template <int DEPTH = 1>
__device__ __forceinline__ void gemm_mainloop(f32x4 (&acc)[4][4], const u16* __restrict__ A, int lda,
                                              const u16* __restrict__ Bt, int ldb, int K, char* smem) {
  u16* As = (u16*)smem;
  u16* Bs = As + 2 * 128 * 64;
  const int tid = threadIdx.x, lane = tid & 63, wave = tid >> 6, wm = wave >> 1, wn = wave & 1;
  const int lr = tid >> 3, lc = (tid & 7) * 8;
  const int lcs = ((tid & 7) ^ ((lr >> 1) & 7)) * 8;
  const int sw = (lane & 15) >> 1;
  const int fo0 = (lane & 15) * 64 + (((lane >> 4) ^ sw) * 8), fo1 = (lane & 15) * 64 + ((((lane >> 4) ^ sw) ^ 4) * 8);
  u32x4v ra0, ra1, ra2, ra3, rb0, rb1, rb2, rb3;
  u32x4v qa0, qa1, qa2, qa3, qb0, qb1, qb2, qb3;
  const __amdgpu_buffer_rsrc_t rsA = __builtin_amdgcn_make_buffer_rsrc((void*)A, 0, 0x7fffffff, 0x00020000);
  const __amdgpu_buffer_rsrc_t rsB = __builtin_amdgcn_make_buffer_rsrc((void*)Bt, 0, 0x7fffffff, 0x00020000);
  const int oa0 = (int)(((size_t)lr * lda + lc) * 2), oa1 = oa0 + 64 * lda, oa2 = oa0 + 128 * lda, oa3 = oa0 + 192 * lda;
  const int ob0 = (int)(((size_t)lr * ldb + lc) * 2), ob1 = ob0 + 64 * ldb, ob2 = ob0 + 128 * ldb, ob3 = ob0 + 192 * ldb;
#define GL_LOAD_X(k0) {                                                              \
  const int ko_ = (int)(k0) * 2;                                                     \
  ra0 = __builtin_amdgcn_raw_buffer_load_b128(rsA, oa0, ko_, 0); rb0 = __builtin_amdgcn_raw_buffer_load_b128(rsB, ob0, ko_, 0); \
  ra1 = __builtin_amdgcn_raw_buffer_load_b128(rsA, oa1, ko_, 0); rb1 = __builtin_amdgcn_raw_buffer_load_b128(rsB, ob1, ko_, 0); \
  ra2 = __builtin_amdgcn_raw_buffer_load_b128(rsA, oa2, ko_, 0); rb2 = __builtin_amdgcn_raw_buffer_load_b128(rsB, ob2, ko_, 0); \
  ra3 = __builtin_amdgcn_raw_buffer_load_b128(rsA, oa3, ko_, 0); rb3 = __builtin_amdgcn_raw_buffer_load_b128(rsB, ob3, ko_, 0); }
#define GL_LOAD_Y(k0) {                                                              \
  const int ko_ = (int)(k0) * 2;                                                     \
  qa0 = __builtin_amdgcn_raw_buffer_load_b128(rsA, oa0, ko_, 0); qb0 = __builtin_amdgcn_raw_buffer_load_b128(rsB, ob0, ko_, 0); \
  qa1 = __builtin_amdgcn_raw_buffer_load_b128(rsA, oa1, ko_, 0); qb1 = __builtin_amdgcn_raw_buffer_load_b128(rsB, ob1, ko_, 0); \
  qa2 = __builtin_amdgcn_raw_buffer_load_b128(rsA, oa2, ko_, 0); qb2 = __builtin_amdgcn_raw_buffer_load_b128(rsB, ob2, ko_, 0); \
  qa3 = __builtin_amdgcn_raw_buffer_load_b128(rsA, oa3, ko_, 0); qb3 = __builtin_amdgcn_raw_buffer_load_b128(rsB, ob3, ko_, 0); }
#define LDS_STORE_X(Ad, Bd)                                                          \
  *(u32x4v*)((Ad) + (lr) * 64 + lcs) = ra0;      *(u32x4v*)((Bd) + (lr) * 64 + lcs) = rb0;      \
  *(u32x4v*)((Ad) + (lr + 32) * 64 + lcs) = ra1; *(u32x4v*)((Bd) + (lr + 32) * 64 + lcs) = rb1; \
  *(u32x4v*)((Ad) + (lr + 64) * 64 + lcs) = ra2; *(u32x4v*)((Bd) + (lr + 64) * 64 + lcs) = rb2; \
  *(u32x4v*)((Ad) + (lr + 96) * 64 + lcs) = ra3; *(u32x4v*)((Bd) + (lr + 96) * 64 + lcs) = rb3;
#define LDS_STORE_Y(Ad, Bd)                                                          \
  *(u32x4v*)((Ad) + (lr) * 64 + lcs) = qa0;      *(u32x4v*)((Bd) + (lr) * 64 + lcs) = qb0;      \
  *(u32x4v*)((Ad) + (lr + 32) * 64 + lcs) = qa1; *(u32x4v*)((Bd) + (lr + 32) * 64 + lcs) = qb1; \
  *(u32x4v*)((Ad) + (lr + 64) * 64 + lcs) = qa2; *(u32x4v*)((Bd) + (lr + 64) * 64 + lcs) = qb2; \
  *(u32x4v*)((Ad) + (lr + 96) * 64 + lcs) = qa3; *(u32x4v*)((Bd) + (lr + 96) * 64 + lcs) = qb3;
#define MMA_STEP(Ab, Bb)                                                             \
  __builtin_amdgcn_s_setprio(1);                                                     \
  _Pragma("unroll") for (int ks = 0; ks < 2; ++ks) {                                 \
    bf16x8 af[4], bfr[4];                                                            \
    const int fo_ = ks ? fo1 : fo0;                                                  \
    _Pragma("unroll") for (int mi = 0; mi < 4; ++mi)                                 \
      af[mi] = *(const bf16x8*)((Ab) + (wm * 64 + mi * 16) * 64 + fo_);              \
    _Pragma("unroll") for (int ni = 0; ni < 4; ++ni)                                 \
      bfr[ni] = *(const bf16x8*)((Bb) + (wn * 64 + ni * 16) * 64 + fo_);             \
    _Pragma("unroll") for (int mi = 0; mi < 4; ++mi)                                 \
    _Pragma("unroll") for (int ni = 0; ni < 4; ++ni) acc[mi][ni] = mfma16(bfr[ni], af[mi], acc[mi][ni]); \
  }                                                                                  \
  __builtin_amdgcn_s_setprio(0);
  u16* As1 = As + 128 * 64;
  u16* Bs1 = Bs + 128 * 64;
  const int nk = K >> 6;
  if (DEPTH == 1) {
    GL_LOAD_X(0)
    LDS_STORE_X(As, Bs)
    __syncthreads();
    for (int kt = 0; kt < nk; kt += 2) {
      GL_LOAD_X((kt + 1) << 6)
      __builtin_amdgcn_sched_barrier(0);
      MMA_STEP(As, Bs)
      __builtin_amdgcn_sched_barrier(0);
      LDS_STORE_X(As1, Bs1)
      __syncthreads();
      if (kt + 2 < nk) { GL_LOAD_X((kt + 2) << 6) }
      __builtin_amdgcn_sched_barrier(0);
      MMA_STEP(As1, Bs1)
      __builtin_amdgcn_sched_barrier(0);
      if (kt + 2 < nk) { LDS_STORE_X(As, Bs) }
      __syncthreads();
    }
  } else {
    GL_LOAD_X(0)
    LDS_STORE_X(As, Bs)
    GL_LOAD_X(64)
    if (nk > 2) { GL_LOAD_Y(128) }
    __syncthreads();
    for (int kt = 0; kt < nk; kt += 2) {
      __builtin_amdgcn_sched_barrier(0);
      MMA_STEP(As, Bs)
      __builtin_amdgcn_sched_barrier(0);
      LDS_STORE_X(As1, Bs1)
      if (kt + 3 < nk) { GL_LOAD_X((kt + 3) << 6) }
      __syncthreads();
      __builtin_amdgcn_sched_barrier(0);
      MMA_STEP(As1, Bs1)
      __builtin_amdgcn_sched_barrier(0);
      if (kt + 2 < nk) { LDS_STORE_Y(As, Bs) }
      if (kt + 4 < nk) { GL_LOAD_Y((kt + 4) << 6) }
      __syncthreads();
    }
  }
#undef GL_LOAD_X
#undef GL_LOAD_Y
#undef LDS_STORE_X
#undef LDS_STORE_Y
#undef MMA_STEP
}

__device__ __forceinline__ void zero_acc(f32x4 (&acc)[4][4]) {
#pragma unroll
  for (int i = 0; i < 4; ++i)
#pragma unroll
    for (int j = 0; j < 4; ++j) acc[i][j] = f32x4{0.f, 0.f, 0.f, 0.f};
}

__device__ __forceinline__ int opaque0() {
  int z;
  asm volatile("v_mov_b32 %0, 0" : "=v"(z));
  return z;
}
#define EPIV_BEGIN {                                                            \
  const int lz = lane + opaque0();                                              \
  _Pragma("unroll") for (int mi = 0; mi < 4; ++mi) {
#define EPIV_INNER                                                              \
  _Pragma("unroll") for (int ni = 0; ni < 4; ++ni) {                            \
    const int lrow = wm * 64 + mi * 16 + (lz & 15);                             \
    const int lcol0 = wn * 64 + ni * 16 + (lz >> 4) * 4;
#define EPIV_INNER_END }
#define EPIV_MID __builtin_amdgcn_sched_barrier(0);
#define EPIV_END __builtin_amdgcn_sched_barrier(0); } }
__device__ __forceinline__ uint2 pack4(f32x4 v) { uint2 r; r.x = pack2(v[0], v[1]); r.y = pack2(v[2], v[3]); return r; }
__device__ __forceinline__ f32x4 unpack4(uint2 u) { return f32x4{bflo(u.x), bfhi(u.x), bflo(u.y), bfhi(u.y)}; }
__device__ __forceinline__ f32x4 sigmoid4(f32x4 v) { return f32x4{sigmoidf_(v[0]), sigmoidf_(v[1]), sigmoidf_(v[2]), sigmoidf_(v[3])}; }


__device__ __forceinline__ void gemm_mainloop_big(f32x4 (&acc)[8][4], const u16* __restrict__ A, int lda,
                                                  const u16* __restrict__ Bt, int ldb, int K, char* smem) {
  u16* As = (u16*)smem;
  u16* Bs = As + 2 * 256 * 32;
  const int tid = threadIdx.x, lane = tid & 63, wave = tid >> 6, wm = wave >> 1, wn = wave & 1;
  const int r4 = tid >> 2;
  const int lcs = ((tid & 3) ^ ((0 - (r4 >> 2)) & 3)) * 8;
  const int fo = (lane & 15) * 32 + (((lane >> 4) ^ ((0 - ((lane & 15) >> 2)) & 3)) * 8);
  const __amdgpu_buffer_rsrc_t rsA = __builtin_amdgcn_make_buffer_rsrc((void*)A, 0, 0x7fffffff, 0x00020000);
  const __amdgpu_buffer_rsrc_t rsB = __builtin_amdgcn_make_buffer_rsrc((void*)Bt, 0, 0x7fffffff, 0x00020000);
  const int oa0 = (r4 * lda + (tid & 3) * 8) * 2, oa1 = oa0 + 128 * lda, oa2 = oa0 + 256 * lda, oa3 = oa0 + 384 * lda;
  const int ob0 = (r4 * ldb + (tid & 3) * 8) * 2, ob1 = ob0 + 128 * ldb;
  u32x4v a0, a1, a2, a3, b0, b1;
#define BG_LOAD(k0) {                                                                \
  const int ko_ = (int)(k0) * 2;                                                     \
  a0 = __builtin_amdgcn_raw_buffer_load_b128(rsA, oa0, ko_, 0); b0 = __builtin_amdgcn_raw_buffer_load_b128(rsB, ob0, ko_, 0); \
  a1 = __builtin_amdgcn_raw_buffer_load_b128(rsA, oa1, ko_, 0); b1 = __builtin_amdgcn_raw_buffer_load_b128(rsB, ob1, ko_, 0); \
  a2 = __builtin_amdgcn_raw_buffer_load_b128(rsA, oa2, ko_, 0);                      \
  a3 = __builtin_amdgcn_raw_buffer_load_b128(rsA, oa3, ko_, 0); }
#define BG_STORE(Ad, Bd)                                                             \
  *(u32x4v*)((Ad) + (r4) * 32 + lcs) = a0;       *(u32x4v*)((Ad) + (r4 + 64) * 32 + lcs) = a1;  \
  *(u32x4v*)((Ad) + (r4 + 128) * 32 + lcs) = a2; *(u32x4v*)((Ad) + (r4 + 192) * 32 + lcs) = a3; \
  *(u32x4v*)((Bd) + (r4) * 32 + lcs) = b0;       *(u32x4v*)((Bd) + (r4 + 64) * 32 + lcs) = b1;
#define BG_MMA(Ab, Bb) {                                                             \
    __builtin_amdgcn_s_setprio(1);                                                   \
    bf16x8 bfr[4];                                                                   \
    _Pragma("unroll") for (int ni = 0; ni < 4; ++ni)                                 \
      bfr[ni] = *(const bf16x8*)((Bb) + (wn * 64 + ni * 16) * 32 + fo);              \
    _Pragma("unroll") for (int mh = 0; mh < 2; ++mh) {                               \
      bf16x8 af[4];                                                                  \
      _Pragma("unroll") for (int mi = 0; mi < 4; ++mi)                               \
        af[mi] = *(const bf16x8*)((Ab) + (wm * 128 + (mh * 4 + mi) * 16) * 32 + fo); \
      _Pragma("unroll") for (int mi = 0; mi < 4; ++mi)                               \
      _Pragma("unroll") for (int ni = 0; ni < 4; ++ni)                               \
        acc[mh * 4 + mi][ni] = mfma16(bfr[ni], af[mi], acc[mh * 4 + mi][ni]);        \
    }                                                                                \
    __builtin_amdgcn_s_setprio(0); }
  u16* As1 = As + 256 * 32;
  u16* Bs1 = Bs + 128 * 32;
  const int nk = K >> 5;
  BG_LOAD(0)
  BG_STORE(As, Bs)
  __syncthreads();
  for (int kt = 0; kt < nk; kt += 2) {
    BG_LOAD((kt + 1) << 5)
    __builtin_amdgcn_sched_barrier(0);
    BG_MMA(As, Bs)
    __builtin_amdgcn_sched_barrier(0);
    BG_STORE(As1, Bs1)
    __syncthreads();
    if (kt + 2 < nk) { BG_LOAD((kt + 2) << 5) }
    __builtin_amdgcn_sched_barrier(0);
    BG_MMA(As1, Bs1)
    __builtin_amdgcn_sched_barrier(0);
    if (kt + 2 < nk) { BG_STORE(As, Bs) }
    __syncthreads();
  }
#undef BG_LOAD
#undef BG_STORE
#undef BG_MMA
}
__device__ __forceinline__ void zero_acc8(f32x4 (&acc)[8][4]) {
#pragma unroll
  for (int i = 0; i < 8; ++i)
#pragma unroll
    for (int j = 0; j < 4; ++j) acc[i][j] = f32x4{0.f, 0.f, 0.f, 0.f};
}
#define EPIV8_BEGIN {                                                           \
  const int lz = lane + opaque0();                                              \
  _Pragma("unroll") for (int mi = 0; mi < 8; ++mi) {
#define EPIV8_INNER                                                             \
  _Pragma("unroll") for (int ni = 0; ni < 4; ++ni) {                            \
    const int lrow = wm * 128 + mi * 16 + (lz & 15);                            \
    const int lcol0 = wn * 64 + ni * 16 + (lz >> 4) * 4;

__device__ void transpose_cvt(const float* __restrict__ src, int K, int N, u16* __restrict__ dst, int Npad,
                              int mode, char* smem, const int nb) {
  float* tile = (float*)smem;
  const int tid = threadIdx.x;
  const int nkt = K / 64, nnt = Npad / 64;
  for (int u = blockIdx.x; u < nkt * nnt; u += nb) {
    const int kt = u % nkt, nt = u / nkt;
    const int k0 = kt * 64, n0 = nt * 64;
#pragma unroll
    for (int i = 0; i < 4; ++i) {
      const int e = tid + i * 256;
      const int kk = e >> 4, nq = (e & 15) * 4;
      const int n = n0 + nq;
      int sc = n;
      if (mode == 1) sc = n < 5120 ? n : (n < 9216 ? n + 16 : (n < 9232 ? n - 9216 + 5120 : -1));
      float4 v = float4{0.f, 0.f, 0.f, 0.f};
      if (sc >= 0) v = *(const float4*)(src + (size_t)(k0 + kk) * N + sc);
      tile[kk * 65 + nq + 0] = v.x; tile[kk * 65 + nq + 1] = v.y; tile[kk * 65 + nq + 2] = v.z; tile[kk * 65 + nq + 3] = v.w;
    }
    __syncthreads();
#pragma unroll
    for (int i = 0; i < 8; ++i) {
      const int e = tid + i * 256;
      const int nn = e >> 5, kp = (e & 31) * 2;
      const unsigned w = pack2(tile[kp * 65 + nn], tile[(kp + 1) * 65 + nn]);
      *(unsigned*)(dst + (size_t)(n0 + nn) * K + k0 + kp) = w;
    }
    __syncthreads();
  }
}

__device__ void cvt_straight(const float* __restrict__ src, u16* __restrict__ dst, size_t n, const int nb) {
  const size_t n4 = n >> 2, stride = (size_t)nb * 256;
  size_t i = (size_t)blockIdx.x * 256 + threadIdx.x;
  for (; i + 3 * stride < n4; i += 4 * stride) {
    const float4 v0 = ((const float4*)src)[i], v1 = ((const float4*)src)[i + stride];
    const float4 v2 = ((const float4*)src)[i + 2 * stride], v3 = ((const float4*)src)[i + 3 * stride];
    uint2 o;
    o.x = pack2(v0.x, v0.y); o.y = pack2(v0.z, v0.w); ((uint2*)dst)[i] = o;
    o.x = pack2(v1.x, v1.y); o.y = pack2(v1.z, v1.w); ((uint2*)dst)[i + stride] = o;
    o.x = pack2(v2.x, v2.y); o.y = pack2(v2.z, v2.w); ((uint2*)dst)[i + 2 * stride] = o;
    o.x = pack2(v3.x, v3.y); o.y = pack2(v3.z, v3.w); ((uint2*)dst)[i + 3 * stride] = o;
  }
  for (; i < n4; i += stride) {
    const float4 v = ((const float4*)src)[i];
    uint2 o;
    o.x = pack2(v.x, v.y);
    o.y = pack2(v.z, v.w);
    ((uint2*)dst)[i] = o;
  }
}

__device__ void cvt_fp8(const float* __restrict__ src, unsigned char* __restrict__ dst, size_t n, float scale, const int nb) {
  const size_t n8 = n >> 3;
  for (size_t i = (size_t)blockIdx.x * 256 + threadIdx.x; i < n8; i += (size_t)nb * 256) {
    float4 a = ((const float4*)src)[2 * i], b = ((const float4*)src)[2 * i + 1];
    int w0 = 0, w1 = 0;
    w0 = __builtin_amdgcn_cvt_pk_fp8_f32(a.x * scale, a.y * scale, w0, false);
    w0 = __builtin_amdgcn_cvt_pk_fp8_f32(a.z * scale, a.w * scale, w0, true);
    w1 = __builtin_amdgcn_cvt_pk_fp8_f32(b.x * scale, b.y * scale, w1, false);
    w1 = __builtin_amdgcn_cvt_pk_fp8_f32(b.z * scale, b.w * scale, w1, true);
    uint2 o;
    o.x = (unsigned)w0;
    o.y = (unsigned)w1;
    ((uint2*)dst)[i] = o;
  }
}

__device__ __forceinline__ void cvt_fp8_chunk(const float* __restrict__ src, unsigned char* __restrict__ dst, float scale) {
#pragma unroll 2
  for (int it = 0; it < 32; ++it) {
    const size_t i = (size_t)it * 256 + threadIdx.x;
    float4 a = ((const float4*)src)[2 * i], b = ((const float4*)src)[2 * i + 1];
    int w0 = 0, w1 = 0;
    w0 = __builtin_amdgcn_cvt_pk_fp8_f32(a.x * scale, a.y * scale, w0, false);
    w0 = __builtin_amdgcn_cvt_pk_fp8_f32(a.z * scale, a.w * scale, w0, true);
    w1 = __builtin_amdgcn_cvt_pk_fp8_f32(b.x * scale, b.y * scale, w1, false);
    w1 = __builtin_amdgcn_cvt_pk_fp8_f32(b.z * scale, b.w * scale, w1, true);
    uint2 o;
    o.x = (unsigned)w0;
    o.y = (unsigned)w1;
    ((uint2*)dst)[i] = o;
  }
}

__device__ void phase0(const Params& P, char* smem) {
  char* ws = P.ws;
  transpose_cvt(P.w_in, 2048, 9232, (u16*)(ws + OFF_WIN), NWIN, 1, smem, P.nblk);
  transpose_cvt(P.w_glu, 1024, 1024, (u16*)(ws + OFF_WGLU), 1024, 0, smem, P.nblk);
  transpose_cvt(P.w_up_ssm, 1024, 2048, (u16*)(ws + OFF_WUPS), 2048, 0, smem, P.nblk);
  transpose_cvt(P.w_up_ml, 1024, 2048, (u16*)(ws + OFF_WUPM), 2048, 0, smem, P.nblk);
  transpose_cvt(P.w_out, 2048, 2048, (u16*)(ws + OFF_WOUT), 2048, 0, smem, P.nblk);
  transpose_cvt(P.peer_wq, 2048, 2048, (u16*)(ws + OFF_WQ), 2048, 0, smem, P.nblk);
  transpose_cvt(P.ple_wg, 2048, 2048, (u16*)(ws + OFF_WPG), 2048, 0, smem, P.nblk);
  transpose_cvt(P.ple_wp, 256, 2048, (u16*)(ws + OFF_WPP), 2048, 0, smem, P.nblk);
  cvt_straight(P.peer_keys, (u16*)(ws + OFF_KEYS), (size_t)8 * 2 * 128 * 128, P.nblk);
  cvt_straight(P.x, (u16*)(ws + OFF_A0), (size_t)T_TOK * 2048, P.nblk);
  cvt_straight(P.p, (u16*)(ws + OFF_PB), (size_t)T_TOK * 256, P.nblk);
  {
    float* sp = (float*)(ws + OFF_SP);
    const int gt = blockIdx.x * 256 + threadIdx.x, gs = P.nblk * 256;
    for (int i = gt; i < 8; i += gs) { sp[SP_BIG + i] = P.b_ig[i]; sp[SP_BFG + i] = P.b_fg[i]; }
    for (int i = gt; i < 8192; i += gs) sp[SP_CONV + i] = P.conv_qk[i];
    for (int i = gt; i < 1024; i += gs) { sp[SP_MHW + i] = P.mh_norm_w[i]; sp[SP_SSMD + i] = P.ssm_d[i]; sp[SP_BGLU + i] = P.b_glu[i]; }
    for (int i = gt; i < 65536; i += gs) { sp[SP_CRE + i] = P.c_re[i]; sp[SP_CIM + i] = P.c_im[i]; }
    for (int i = gt; i < 2048; i += gs) { sp[SP_LN1G + i] = P.ln1_g[i]; sp[SP_LN1B + i] = P.ln1_b[i]; sp[SP_LN2G + i] = P.ln2_g[i]; sp[SP_LN2B + i] = P.ln2_b[i]; }
  }
  if (blockIdx.x == 0 && threadIdx.x == 0) {
    const float** pt = (const float**)(ws + OFF_TCTR + 64);
    pt[0] = P.peer_u;
    pt[1] = P.peer_v;
  }
  float* lam_r = (float*)(ws + OFF_S5P);
  float* lam_i = lam_r + 4096;
  float* bbar_r = lam_i + 4096;
  float* bbar_i = bbar_r + 65536;
  for (int i = blockIdx.x * 256 + threadIdx.x; i < 4096; i += P.nblk * 256) {
    const int g = i >> 6;
    const double ar = P.a_re[i], ai = P.a_im[i];
    const double dt = (double)expf(P.log_dt[g]);
    const double mag = (double)expf((float)(dt * ar));
    const double ang = dt * ai;
    const double kq = rint(ang * 0.15915494309189535);
    const float red = (float)(ang - kq * 6.283185307179586);
    const double lr = mag * (double)cosf(red), li = mag * (double)sinf(red);
    const double den = ar * ar + ai * ai;
    const double zr = ((lr - 1.0) * ar + li * ai) / den;
    const double zi = (li * ar - (lr - 1.0) * ai) / den;
    lam_r[i] = (float)lr;
    lam_i[i] = (float)li;
#pragma unroll 4
    for (int c = 0; c < 16; ++c) {
      const double br = P.b_re[i * 16 + c], bi = P.b_im[i * 16 + c];
      bbar_r[i * 16 + c] = (float)(zr * br - zi * bi);
      bbar_i[i * 16 + c] = (float)(zr * bi + zi * br);
    }
  }
}

#define SPF ((const float*)(P.ws + OFF_SP))
template <int DEPTH>
__device__ __forceinline__ void p1_tile(const Params& P, char* smem, const int mt, const int nt) {
  char* ws = P.ws;
  const u16* xb = (const u16*)(ws + OFF_A0);
  const u16* wt = (const u16*)(ws + OFF_WIN);
  float* us = (float*)(ws + OFF_A1);
  u16* qkvo = (u16*)(ws + OFF_A2);
  u16* gates = (u16*)(ws + OFF_A3);
  float* ifg = (float*)(ws + OFF_IF);
  const int tid = threadIdx.x, lane = tid & 63, wave = tid >> 6, wm = wave >> 1, wn = wave & 1;
  {

    const int m0 = mt * 128, n0 = nt * 128;
    f32x4 acc[4][4];
    zero_acc(acc);
    gemm_mainloop<DEPTH>(acc, xb + (size_t)m0 * 2048, 2048, wt + (size_t)n0 * 2048, 2048, 2048, smem);
    if (n0 < 1024) {
      EPIV_BEGIN EPIV_INNER
        *(f32x4*)(us + (size_t)(m0 + lrow) * 1024 + n0 + lcol0) = acc[mi][ni];
      EPIV_INNER_END EPIV_END
    } else if (n0 < 4096) {
      EPIV_BEGIN EPIV_INNER
        *(uint2*)(qkvo + (size_t)(m0 + lrow) * 4096 + (n0 - 1024) + lcol0) = pack4(acc[mi][ni]);
      EPIV_INNER_END EPIV_END
    } else if (n0 < 5120) {
      EPIV_BEGIN EPIV_INNER
        *(uint2*)(qkvo + (size_t)(m0 + lrow) * 4096 + (n0 - 1024) + lcol0) = pack4(sigmoid4(acc[mi][ni]));
      EPIV_INNER_END EPIV_END
    } else if (n0 < 9216) {
      EPIV_BEGIN EPIV_INNER
        *(uint2*)(gates + (size_t)(m0 + lrow) * 4096 + (n0 - 5120) + lcol0) = pack4(sigmoid4(acc[mi][ni]));
      EPIV_INNER_END EPIV_END
    } else {
      EPIV_BEGIN EPIV_INNER
        if (lcol0 < 16) {
          f32x4 v = acc[mi][ni];
#pragma unroll
          for (int j = 0; j < 4; ++j) v[j] += (lcol0 + j) < 8 ? (SPF + SP_BIG)[lcol0 + j] : (SPF + SP_BFG)[lcol0 + j - 8];
          *(f32x4*)(ifg + (size_t)(m0 + lrow) * 16 + lcol0) = v;
        }
      EPIV_INNER_END EPIV_END
    }
  }
}

__device__ void phase1(const Params& P, char* smem) {
  for (int tile = blockIdx.x; tile < 64 * 40; tile += P.nblk) {
    const int mt = tile & 63, i = tile >> 6;
    p1_tile<2>(P, smem, mt, i < 39 ? i : 72);
  }
}

__device__ void phase1c(const Params& P, char* smem) {
  char* ws = P.ws;
  const u16* qkvo = (const u16*)(ws + OFF_A2);
  u16* qkc = (u16*)(ws + OFF_QKC);
  const int gt = blockIdx.x * 256 + threadIdx.x, gs = P.nblk * 256;
  for (int item = gt; item < (T_TOK / 8) * 256; item += gs) {
    const int cg = item & 255, tb = item >> 8;
    const int col = cg * 8;
    const int tok0 = tb * 8, sp0 = tok0 & 2047;
    float cw[4][8];
#pragma unroll
    for (int j = 0; j < 4; ++j)
#pragma unroll
      for (int i = 0; i < 8; ++i) cw[j][i] = (SPF + SP_CONV)[j * 2048 + col + i];
    const float kscale = col >= 1024 ? 0.08838834764831845f : 1.f;
    const u16* base = qkvo + (size_t)(tok0 - sp0) * 4096 + col;
    float x0[8], x1[8], x2[8], x3[8];
    auto ldrow = [&](int sp, float (&dst)[8]) {
      if (sp >= 0) {
        uint4 r = *(const uint4*)(base + (size_t)sp * 4096);
        dst[0] = bflo(r.x); dst[1] = bfhi(r.x); dst[2] = bflo(r.y); dst[3] = bfhi(r.y);
        dst[4] = bflo(r.z); dst[5] = bfhi(r.z); dst[6] = bflo(r.w); dst[7] = bfhi(r.w);
      } else {
#pragma unroll
        for (int i = 0; i < 8; ++i) dst[i] = 0.f;
      }
    };
    ldrow(sp0 - 3, x0);
    ldrow(sp0 - 2, x1);
    ldrow(sp0 - 1, x2);
#pragma unroll
    for (int r = 0; r < 8; ++r) {
      ldrow(sp0 + r, x3);
      float o[8];
#pragma unroll
      for (int i = 0; i < 8; ++i) {
        float c = cw[0][i] * x0[i] + cw[1][i] * x1[i] + cw[2][i] * x2[i] + cw[3][i] * x3[i];
        o[i] = c * sigmoidf_(c) * kscale;
      }
      uint4 w;
      w.x = pack2(o[0], o[1]); w.y = pack2(o[2], o[3]); w.z = pack2(o[4], o[5]); w.w = pack2(o[6], o[7]);
      *(uint4*)(qkc + (size_t)(tok0 + r) * 2048 + col) = w;
#pragma unroll
      for (int i = 0; i < 8; ++i) { x0[i] = x1[i]; x1[i] = x2[i]; x2[i] = x3[i]; }
    }
  }
}

__device__ void s5_unit(const Params& P, int unit, char* smem) {
  char* ws = P.ws;
  const int tid = threadIdx.x, lane = tid & 63, wave = tid >> 6;
  const int b = unit >> 4, g = (unit & 15) * 4 + wave;
  float* BU = (float*)(smem + wave * 13568);
  u16* Sb = (u16*)(smem + wave * 13568 + 8192);
  const float* us = (const float*)(ws + OFF_A1);
  u16* yg = (u16*)(ws + OFF_A4);
  const float* lam_r = (const float*)(ws + OFF_S5P);
  const float* lam_i = lam_r + 4096;
  const float* bbar_r = lam_i + 4096;
  const float* bbar_i = bbar_r + 65536;
  const int l15 = lane & 15, lq = lane >> 4;
  bf16x8 bfr[8];
#pragma unroll
  for (int nt = 0; nt < 8; ++nt) {
    const int n = nt * 16 + l15;
    bf16x8 v = {0, 0, 0, 0, 0, 0, 0, 0};
    if (lq < 2) {
      const float* src = (n < 64) ? (bbar_r + ((size_t)(g * 64 + n) * 16 + lq * 8))
                                  : (bbar_i + ((size_t)(g * 64 + n - 64) * 16 + lq * 8));
#pragma unroll
      for (int jj = 0; jj < 8; ++jj) v[jj] = (short)f2bf(src[jj]);
    }
    bfr[nt] = v;
  }
  const float dsk = (SPF + SP_SSMD)[g * 16 + l15];
  bf16x8 cfr[5];
#pragma unroll
  for (int ks = 0; ks < 5; ++ks) {
    const int nb = ks * 32 + lq * 8;
    bf16x8 v;
#pragma unroll
    for (int jj = 0; jj < 8; ++jj) {
      const int n = nb + jj;
      float val;
      if (n < 64) val = (SPF + SP_CRE)[(size_t)(g * 16 + l15) * 64 + n];
      else if (n < 128) val = -(SPF + SP_CIM)[(size_t)(g * 16 + l15) * 64 + (n - 64)];
      else val = (n - 128 == l15) ? dsk : 0.f;
      v[jj] = (short)f2bf(val);
    }
    cfr[ks] = v;
  }
  const float lr = lam_r[g * 64 + lane], li = lam_i[g * 64 + lane];
  float sr = 0.f, si = 0.f;
  float4 pv0 = float4{0.f, 0.f, 0.f, 0.f}, pv1 = pv0;
  if (lq < 2) {
    const float* src = us + (size_t)(b * 2048 + l15) * 1024 + g * 16 + lq * 8;
    pv0 = *(const float4*)src; pv1 = *(const float4*)(src + 4);
  }
  for (int sc = 0; sc < 128; ++sc) {
    const int t0 = b * 2048 + sc * 16;
    {
      bf16x8 af;
      af[0] = (short)f2bf(pv0.x); af[1] = (short)f2bf(pv0.y); af[2] = (short)f2bf(pv0.z); af[3] = (short)f2bf(pv0.w);
      af[4] = (short)f2bf(pv1.x); af[5] = (short)f2bf(pv1.y); af[6] = (short)f2bf(pv1.z); af[7] = (short)f2bf(pv1.w);
      if (lq < 2 && sc + 1 < 128) {
        const float* src = us + (size_t)(t0 + 16 + l15) * 1024 + g * 16 + lq * 8;
        pv0 = *(const float4*)src; pv1 = *(const float4*)(src + 4);
      }
      *(bf16x8*)(Sb + l15 * 168 + 128 + lq * 8) = af;
#pragma unroll
      for (int nt = 0; nt < 8; ++nt) {
        f32x4 a = mfma16(af, bfr[nt], f32x4{0.f, 0.f, 0.f, 0.f});
#pragma unroll
        for (int jj = 0; jj < 4; ++jj) BU[(lq * 4 + jj) * 128 + nt * 16 + l15] = a[jj];
      }
    }
    __builtin_amdgcn_fence(__ATOMIC_RELEASE, "wavefront");
    __builtin_amdgcn_wave_barrier();
    __builtin_amdgcn_fence(__ATOMIC_ACQUIRE, "wavefront");
    {
      float bre[16], bim[16];
#pragma unroll
      for (int t = 0; t < 16; ++t) { bre[t] = BU[t * 128 + lane]; bim[t] = BU[t * 128 + 64 + lane]; }
#pragma unroll
      for (int t = 0; t < 16; ++t) {
        const float nsr = lr * sr - li * si + bre[t];
        const float nsi = lr * si + li * sr + bim[t];
        sr = nsr; si = nsi;
        bre[t] = sr; bim[t] = si;
      }
#pragma unroll
      for (int t = 0; t < 16; ++t) {
        Sb[t * 168 + lane] = f2bf(bre[t]);
        Sb[t * 168 + 64 + lane] = f2bf(bim[t]);
      }
    }
    __builtin_amdgcn_fence(__ATOMIC_RELEASE, "wavefront");
    __builtin_amdgcn_wave_barrier();
    __builtin_amdgcn_fence(__ATOMIC_ACQUIRE, "wavefront");
    {
      f32x4 a = {0.f, 0.f, 0.f, 0.f};
#pragma unroll
      for (int ks = 0; ks < 5; ++ks) {
        bf16x8 af = *(const bf16x8*)(Sb + l15 * 168 + ks * 32 + lq * 8);
        a = mfma16(af, cfr[ks], a);
      }
#pragma unroll
      for (int jj = 0; jj < 4; ++jj) {
        const size_t t = (size_t)t0 + lq * 4 + jj;
        yg[t * 1024 + g * 16 + l15] = f2bf(gelu_tanh(a[jj]));
      }
    }
    __builtin_amdgcn_fence(__ATOMIC_RELEASE, "wavefront");
    __builtin_amdgcn_wave_barrier();
    __builtin_amdgcn_fence(__ATOMIC_ACQUIRE, "wavefront");
  }
  __syncthreads();
}

__device__ __forceinline__ void lds_barrier() { asm volatile("s_waitcnt lgkmcnt(0)\n\ts_barrier" ::: "memory"); }

__device__ void mlstm_unit(const Params& P, int unit, char* smem) {
  char* ws = P.ws;
  const int b = unit >> 5, h = (unit >> 2) & 7, sl = unit & 3;
  u16* qs = (u16*)smem;
  u16* ks_ = qs + 64 * 136;
  u16* vT = ks_ + 64 * 136;
  u16* wvT = vT + 32 * 72;
  u16* scs = wvT + 32 * 72;
  u16* CT = scs + 64 * 72;
  float* fl = (float*)(CT + 32 * 136);
  float* es = fl;
  float* rts = fl + 64;
  float* isc = fl + 128;
  float* emr = fl + 192;
  float* wts = fl + 256;
  float* nst = fl + 320;
  float* qn = fl + 448;
  float* scal = fl + 512;
  u16* wtsb = (u16*)(fl + 520);
  u16* nT = wtsb + 64;
  const u16* qkvo = (const u16*)(ws + OFF_A2);
  const float* ifg = (const float*)(ws + OFF_IF);
  float* hm = (float*)(ws + OFF_A4 + A4_HM);
  const int tid = threadIdx.x, lane = tid & 63, wave = tid >> 6;
  const int l15 = lane & 15, lq = lane >> 4;
  const u16* qkc = (const u16*)(ws + OFF_QKC);
  const int vs = tid >> 2, vdq = (tid & 3) * 8;
  for (int i = tid; i < 32 * 136; i += 256) CT[i] = 0;
  if (tid < 128) { nst[tid] = 0.f; nT[tid] = 0; }
  f32x4 nacc[2];
  nacc[0] = f32x4{0.f, 0.f, 0.f, 0.f};
  nacc[1] = f32x4{0.f, 0.f, 0.f, 0.f};
  f32x4 stacc[2][2];
  stacc[0][0] = f32x4{0.f, 0.f, 0.f, 0.f}; stacc[0][1] = f32x4{0.f, 0.f, 0.f, 0.f};
  stacc[1][0] = f32x4{0.f, 0.f, 0.f, 0.f}; stacc[1][1] = f32x4{0.f, 0.f, 0.f, 0.f};
  float m_st = 0.f;
  uint4 pq0, pq1, pq2, pq3, pq4, pq5, pq6, pq7;
  uint4 pvv;
  float pig = 0.f, pfp = 0.f;
#define ML_PIECE_SRC(i, T0) (qkc + (size_t)((T0) + (((tid + (i) * 256) >> 4) & 63)) * 2048 + ((tid + (i) * 256) >> 10) * 1024 + h * 128 + ((tid + (i) * 256) & 15) * 8)
#define ML_PIECE_DST(i) ((((tid + (i) * 256) >> 10) ? ks_ : qs) + (((tid + (i) * 256) >> 4) & 63) * 136 + ((tid + (i) * 256) & 15) * 8)
#define ML_PREFETCH(T0) {                                                                          \
    pq0 = *(const uint4*)ML_PIECE_SRC(0, T0); pq1 = *(const uint4*)ML_PIECE_SRC(1, T0);            \
    pq2 = *(const uint4*)ML_PIECE_SRC(2, T0); pq3 = *(const uint4*)ML_PIECE_SRC(3, T0);            \
    pq4 = *(const uint4*)ML_PIECE_SRC(4, T0); pq5 = *(const uint4*)ML_PIECE_SRC(5, T0);            \
    pq6 = *(const uint4*)ML_PIECE_SRC(6, T0); pq7 = *(const uint4*)ML_PIECE_SRC(7, T0);            \
    pvv = *(const uint4*)(qkvo + (size_t)((T0) + vs) * 4096 + 2048 + h * 128 + sl * 32 + vdq);     \
    if (wave == 0) { pig = ifg[(size_t)((T0) + lane) * 16 + h]; pfp = ifg[(size_t)((T0) + lane) * 16 + 8 + h]; } }
  ML_PREFETCH(b * 2048)
  __syncthreads();
  for (int chunk = 0; chunk < 32; ++chunk) {
    const int t0 = b * 2048 + chunk * 64;
    *(uint4*)ML_PIECE_DST(0) = pq0; *(uint4*)ML_PIECE_DST(1) = pq1; *(uint4*)ML_PIECE_DST(2) = pq2; *(uint4*)ML_PIECE_DST(3) = pq3;
    *(uint4*)ML_PIECE_DST(4) = pq4; *(uint4*)ML_PIECE_DST(5) = pq5; *(uint4*)ML_PIECE_DST(6) = pq6; *(uint4*)ML_PIECE_DST(7) = pq7;
    float vreg[8];
    {
      vreg[0] = bflo(pvv.x); vreg[1] = bfhi(pvv.x); vreg[2] = bflo(pvv.y); vreg[3] = bfhi(pvv.y);
      vreg[4] = bflo(pvv.z); vreg[5] = bfhi(pvv.z); vreg[6] = bflo(pvv.w); vreg[7] = bfhi(pvv.w);
#pragma unroll
      for (int i = 0; i < 8; ++i) vT[(vdq + i) * 72 + vs] = f2bf(vreg[i]);
    }
    const float ig_c = pig, fp_c = pfp;
    if (chunk + 1 < 32) ML_PREFETCH(t0 + 64)
    if (wave == 0) {
      const float ig = ig_c;
      const float fp = fp_c;
      const float logf = fminf(fp, 0.f) - log1pf(__expf(-fabsf(fp)));
      const float bc = wave_scan_sum(logf);
      const float gtot = rdl(bc, 63);
      const float e = ig - bc;
      const float pm = wave_scan_max(e);
      const float mloc = gtot + rdl(pm, 63);
      const float m_prev = m_st;
      const float m_new = fmaxf(gtot + m_prev, mloc);
      const float a = __expf(gtot + m_prev - m_new);
      const float wl = gtot + e;
      const float rt = -fmaxf(m_prev, pm);
      es[lane] = e;
      rts[lane] = rt;
      isc[lane] = __expf(m_prev + rt);
      emr[lane] = __expf(rt - bc);
      wts[lane] = __expf(wl - m_new);
      wtsb[lane] = f2bf(__expf(wl - m_new));
      if (lane == 0) scal[0] = a;
      m_st = m_new;
    }
    lds_barrier();
#pragma unroll
    for (int i = 0; i < 8; ++i) wvT[(vdq + i) * 72 + vs] = f2bf(wts[vs] * vreg[i]);
    bf16x8 afr[4];
    f32x4 sacc[4];
#pragma unroll
    for (int ni = 0; ni < 4; ++ni) sacc[ni] = f32x4{0.f, 0.f, 0.f, 0.f};
#pragma unroll
    for (int kk = 0; kk < 4; ++kk) {
      afr[kk] = *(const bf16x8*)(qs + (wave * 16 + l15) * 136 + kk * 32 + lq * 8);
#pragma unroll
      for (int ni = 0; ni < 4; ++ni) {
        bf16x8 bb = *(const bf16x8*)(ks_ + (ni * 16 + l15) * 136 + kk * 32 + lq * 8);
        sacc[ni] = mfma16(afr[kk], bb, sacc[ni]);
      }
    }
    float rowsum[4];
#pragma unroll
    for (int jj = 0; jj < 4; ++jj) {
      const int t = wave * 16 + lq * 4 + jj;
      const float rt_t = rts[t];
      float rs = 0.f;
#pragma unroll
      for (int ni = 0; ni < 4; ++ni) {
        const int s = ni * 16 + l15;
        float val = (s <= t) ? sacc[ni][jj] * __expf(rt_t + es[s]) : 0.f;
        rs += val;
        scs[t * 72 + s] = f2bf(val);
      }
      rowsum[jj] = row_sum(rs);
    }
    f32x4 cacc[2];
    cacc[0] = f32x4{0.f, 0.f, 0.f, 0.f};
    cacc[1] = f32x4{0.f, 0.f, 0.f, 0.f};
#pragma unroll
    for (int kk = 0; kk < 4; ++kk) {
#pragma unroll
      for (int dvt = 0; dvt < 2; ++dvt) {
        bf16x8 bb = *(const bf16x8*)(CT + (dvt * 16 + l15) * 136 + kk * 32 + lq * 8);
        cacc[dvt] = mfma16(afr[kk], bb, cacc[dvt]);
      }
    }
    {
      f32x4 qnacc = {0.f, 0.f, 0.f, 0.f};
#pragma unroll
      for (int kk = 0; kk < 4; ++kk) {
        bf16x8 bn = {0, 0, 0, 0, 0, 0, 0, 0};
        if (l15 == 0) bn = *(const bf16x8*)(nT + kk * 32 + lq * 8);
        qnacc = mfma16(afr[kk], bn, qnacc);
      }
      if (l15 == 0) {
#pragma unroll
        for (int jj = 0; jj < 4; ++jj) qn[wave * 16 + lq * 4 + jj] = qnacc[jj];
      }
    }
    lds_barrier();
    {
      f32x4 numa[2];
      numa[0] = f32x4{0.f, 0.f, 0.f, 0.f};
      numa[1] = f32x4{0.f, 0.f, 0.f, 0.f};
#pragma unroll
      for (int kk = 0; kk < 2; ++kk) {
        bf16x8 aa = *(const bf16x8*)(scs + (wave * 16 + l15) * 72 + kk * 32 + lq * 8);
#pragma unroll
        for (int dvt = 0; dvt < 2; ++dvt) {
          bf16x8 bb = *(const bf16x8*)(vT + (dvt * 16 + l15) * 72 + kk * 32 + lq * 8);
          numa[dvt] = mfma16(aa, bb, numa[dvt]);
        }
      }
#pragma unroll
      for (int jj = 0; jj < 4; ++jj) {
        const int t = wave * 16 + lq * 4 + jj;
        const float is = isc[t];
        const float den = rowsum[jj] + is * qn[t];
        const float rden = 1.f / fmaxf(fabsf(den), emr[t]);
#pragma unroll
        for (int dvt = 0; dvt < 2; ++dvt)
          hm[(size_t)(t0 + t) * 1024 + h * 128 + sl * 32 + dvt * 16 + l15] = (numa[dvt][jj] + is * cacc[dvt][jj]) * rden;
      }
    }
    {
      const float a = scal[0];
#pragma unroll
      for (int i = 0; i < 2; ++i) {
        const int sub = wave * 2 + i;
        f32x4 st = stacc[i][0], st1 = stacc[i][1];
        st[0] *= a; st[1] *= a; st[2] *= a; st[3] *= a;
        st1[0] *= a; st1[1] *= a; st1[2] *= a; st1[3] *= a;
        f32x4 na = nacc[i];
        na[0] *= a; na[1] *= a; na[2] *= a; na[3] *= a;
#pragma unroll
        for (int kk = 0; kk < 2; ++kk) {
          bf16x8 aa = *(const bf16x8*)(wvT + l15 * 72 + kk * 32 + lq * 8);
          bf16x8 aa1 = *(const bf16x8*)(wvT + (16 + l15) * 72 + kk * 32 + lq * 8);
          bf16x8 bb;
#pragma unroll
          for (int jj = 0; jj < 8; ++jj) bb[jj] = (short)ks_[(kk * 32 + lq * 8 + jj) * 136 + sub * 16 + l15];
          st = mfma16(aa, bb, st);
          st1 = mfma16(aa1, bb, st1);
          bf16x8 aw = {0, 0, 0, 0, 0, 0, 0, 0};
          if (l15 == 0) aw = *(const bf16x8*)(wtsb + kk * 32 + lq * 8);
          na = mfma16(aw, bb, na);
        }
        stacc[i][0] = st;
        stacc[i][1] = st1;
        nacc[i] = na;
        if (lq == 0) nT[sub * 16 + l15] = f2bf(na[0]);
#pragma unroll
        for (int jj = 0; jj < 4; ++jj) { CT[(lq * 4 + jj) * 136 + sub * 16 + l15] = f2bf(st[jj]); CT[(16 + lq * 4 + jj) * 136 + sub * 16 + l15] = f2bf(st1[jj]); }
      }
    }
    lds_barrier();
  }
}

__device__ void phase2(const Params& P, char* smem) {
  for (int u = blockIdx.x; u < 192; u += P.nblk) {
    if (u < 64) s5_unit(P, u, smem);
    else mlstm_unit(P, u - 64, smem);
  }
  unsigned* ctr = (unsigned*)(P.ws + OFF_TCTR);
  volatile int* s_tile = (volatile int*)(smem + 73728);
  for (;;) {
    __syncthreads();
    if (threadIdx.x == 0) *s_tile = (int)atomicAdd(ctr, 1u);
    __syncthreads();
    const int it = *s_tile;
    if (it >= 3072 + 64) break;
    const int q = it / 3, r = it - q * 3;
    if (it >= 3072) {
      p1_tile<1>(P, smem, it - 3072, 39);
    } else if (r < 2) {
      const int g = 2 * q + r;
      p1_tile<1>(P, smem, g & 63, 40 + (g >> 6));
    } else {
      const size_t off = (size_t)(q & 511) * 65536;
      const float* const* pt = (const float* const*)(P.ws + OFF_TCTR + 64);
      if (q < 512) cvt_fp8_chunk(pt[0] + off, (unsigned char*)(P.ws + OFF_UB) + off, U_SCALE);
      else cvt_fp8_chunk(pt[1] + off, (unsigned char*)(P.ws + OFF_VB) + off, V_SCALE);
    }
  }
}

__device__ void phase3(const Params& P, char* smem) {
  char* ws = P.ws;
  const u16* yg = (const u16*)(ws + OFF_A4);
  const u16* wt = (const u16*)(ws + OFF_WGLU);
  u16* ya = (u16*)(ws + OFF_A1);
  u16* yb = ya + (size_t)T_TOK * 1024;
  const float* hm = (const float*)(ws + OFF_A4 + A4_HM);
  const u16* qkvo = (const u16*)(ws + OFF_A2);
  const int tid = threadIdx.x, lane = tid & 63, wave = tid >> 6, wm = wave >> 1, wn = wave & 1;
  for (int tile = blockIdx.x; tile < 64 * 8; tile += P.nblk) {
    const int mt = tile & 63, nt = tile >> 6;
    const int m0 = mt * 128, n0 = nt * 128;
    f32x4 acc[4][4];
    zero_acc(acc);
    gemm_mainloop(acc, yg + (size_t)m0 * 1024, 1024, wt + (size_t)n0 * 1024, 1024, 1024, smem);
    EPIV_BEGIN
      uint2 yv[4];
      EPIV_INNER
        yv[ni] = *(const uint2*)(yg + (size_t)(m0 + lrow) * 1024 + n0 + lcol0);
      EPIV_INNER_END
      EPIV_MID
      EPIV_INNER
        const f32x4 y = unpack4(yv[ni]);
        const f32x4 bg = *(const f32x4*)((SPF + SP_BGLU) + n0 + lcol0);
        const f32x4 g = sigmoid4(acc[mi][ni] + bg);
        *(uint2*)(ya + (size_t)(m0 + lrow) * 1024 + n0 + lcol0) = pack4(y * g);
      EPIV_INNER_END
    EPIV_END
  }
  for (int t = blockIdx.x * 4 + wave; t < T_TOK; t += P.nblk * 4) {
    const int c0 = (lane >> 3) * 128 + (lane & 7) * 16;
    float v[16], ov[16];
#pragma unroll
    for (int k = 0; k < 4; ++k) {
      const f32x4 a = *(const f32x4*)(hm + (size_t)t * 1024 + c0 + k * 4);
      v[k * 4 + 0] = a[0]; v[k * 4 + 1] = a[1]; v[k * 4 + 2] = a[2]; v[k * 4 + 3] = a[3];
    }
#pragma unroll
    for (int k = 0; k < 2; ++k) {
      const uint4 o = *(const uint4*)(qkvo + (size_t)t * 4096 + 3072 + c0 + k * 8);
      ov[k * 8 + 0] = bflo(o.x); ov[k * 8 + 1] = bfhi(o.x); ov[k * 8 + 2] = bflo(o.y); ov[k * 8 + 3] = bfhi(o.y);
      ov[k * 8 + 4] = bflo(o.z); ov[k * 8 + 5] = bfhi(o.z); ov[k * 8 + 6] = bflo(o.w); ov[k * 8 + 7] = bfhi(o.w);
    }
    float sm = 0.f;
#pragma unroll
    for (int j = 0; j < 16; ++j) sm += v[j];
    sm += dpp_f<0xB1>(sm); sm += dpp_f<0x4E>(sm); sm += dpp_f<0x141>(sm);
    const float mean = sm * (1.f / 128.f);
    float q = 0.f;
#pragma unroll
    for (int j = 0; j < 16; ++j) { v[j] -= mean; q += v[j] * v[j]; }
    q += dpp_f<0xB1>(q); q += dpp_f<0x4E>(q); q += dpp_f<0x141>(q);
    const float rstd = rsqrtf(q * (1.f / 128.f) + 1e-5f);
    float ob[16];
#pragma unroll
    for (int k = 0; k < 4; ++k) {
      const f32x4 wv = *(const f32x4*)(SPF + SP_MHW + c0 + k * 4);
#pragma unroll
      for (int j = 0; j < 4; ++j) ob[k * 4 + j] = ov[k * 4 + j] * v[k * 4 + j] * rstd * wv[j];
    }
    uint4 w0, w1;
    w0.x = pack2(ob[0], ob[1]); w0.y = pack2(ob[2], ob[3]); w0.z = pack2(ob[4], ob[5]); w0.w = pack2(ob[6], ob[7]);
    w1.x = pack2(ob[8], ob[9]); w1.y = pack2(ob[10], ob[11]); w1.z = pack2(ob[12], ob[13]); w1.w = pack2(ob[14], ob[15]);
    *(uint4*)(yb + (size_t)t * 1024 + c0) = w0;
    *(uint4*)(yb + (size_t)t * 1024 + c0 + 8) = w1;
  }
}

__device__ void phase4b(const Params& P, char* smem) {
  char* ws = P.ws;
  const u16* ya = (const u16*)(ws + OFF_A1);
  const u16* yb = ya + (size_t)T_TOK * 1024;
  const u16* w1 = (const u16*)(ws + OFF_WUPS);
  const u16* w2 = (const u16*)(ws + OFF_WUPM);
  const u16* gates = (const u16*)(ws + OFF_A3);
  float* tmpg = (float*)(ws + OFF_A4);
  u16* merged = (u16*)(ws + OFF_A0);
  const int tid = threadIdx.x, lane = tid & 63, wave = tid >> 6, wm = wave >> 1, wn = wave & 1;
  for (int tile = blockIdx.x; tile < 32 * 16; tile += P.nblk) {
    const int mt = tile & 31, nt = tile >> 5;
    const int m0 = mt * 256, n0 = nt * 128;
    f32x4 acc[8][4];
    zero_acc8(acc);
    gemm_mainloop_big(acc, ya + (size_t)m0 * 1024, 1024, w1 + (size_t)n0 * 1024, 1024, 1024, smem);
    EPIV8_BEGIN
      uint2 gv[4];
      EPIV8_INNER
        gv[ni] = *(const uint2*)(gates + (size_t)(m0 + lrow) * 4096 + n0 + lcol0);
      EPIV_INNER_END
      EPIV_MID
      EPIV8_INNER
        *(f32x4*)(tmpg + (size_t)(m0 + lrow) * 2048 + n0 + lcol0) = unpack4(gv[ni]) * acc[mi][ni];
      EPIV_INNER_END
    EPIV_END
    zero_acc8(acc);
    gemm_mainloop_big(acc, yb + (size_t)m0 * 1024, 1024, w2 + (size_t)n0 * 1024, 1024, 1024, smem);
    EPIV8_BEGIN
      uint2 gv[4];
      f32x4 tv[4];
      EPIV8_INNER
        gv[ni] = *(const uint2*)(gates + (size_t)(m0 + lrow) * 4096 + 2048 + n0 + lcol0);
        tv[ni] = *(const f32x4*)(tmpg + (size_t)(m0 + lrow) * 2048 + n0 + lcol0);
      EPIV_INNER_END
      EPIV_MID
      EPIV8_INNER
        *(uint2*)(merged + (size_t)(m0 + lrow) * 2048 + n0 + lcol0) = pack4(tv[ni] + unpack4(gv[ni]) * acc[mi][ni]);
      EPIV_INNER_END
    EPIV_END
  }
}

__device__ void phase5(const Params& P, char* smem) {
  char* ws = P.ws;
  const u16* merged = (const u16*)(ws + OFF_A0);
  const u16* wt = (const u16*)(ws + OFF_WOUT);
  float* r1 = (float*)(ws + OFF_A2);
  const int tid = threadIdx.x, lane = tid & 63, wave = tid >> 6, wm = wave >> 1, wn = wave & 1;
  for (int tile = blockIdx.x; tile < 32 * 16; tile += P.nblk) {
    const int mt = tile & 31, nt = tile >> 5;
    const int m0 = mt * 256, n0 = nt * 128;
    f32x4 acc[8][4];
    zero_acc8(acc);
    gemm_mainloop_big(acc, merged + (size_t)m0 * 2048, 2048, wt + (size_t)n0 * 2048, 2048, 2048, smem);
    EPIV8_BEGIN
      f32x4 xv[4];
      EPIV8_INNER
        xv[ni] = *(const f32x4*)(P.x + (size_t)(m0 + lrow) * 2048 + n0 + lcol0);
      EPIV_INNER_END
      EPIV_MID
      EPIV8_INNER
        *(f32x4*)(r1 + (size_t)(m0 + lrow) * 2048 + n0 + lcol0) = xv[ni] * DN_ALPHA + acc[mi][ni];
      EPIV_INNER_END
    EPIV_END
  }
}

__device__ void phase6(const Params& P, char* smem) {
  char* ws = P.ws;
  float* r1 = (float*)(ws + OFF_A2);
  u16* h1b = (u16*)(ws + OFF_A0);
  const int tid = threadIdx.x, lane = tid & 63, wave = tid >> 6;
  for (int r = blockIdx.x * 4 + wave; r < T_TOK; r += P.nblk * 4) {
    float* row = r1 + (size_t)r * 2048;
    float v[32];
    float s = 0.f;
#pragma unroll
    for (int i = 0; i < 4; ++i) {
      float4 a = *(const float4*)(row + i * 512 + lane * 8);
      float4 c = *(const float4*)(row + i * 512 + lane * 8 + 4);
      v[i * 8 + 0] = a.x; v[i * 8 + 1] = a.y; v[i * 8 + 2] = a.z; v[i * 8 + 3] = a.w;
      v[i * 8 + 4] = c.x; v[i * 8 + 5] = c.y; v[i * 8 + 6] = c.z; v[i * 8 + 7] = c.w;
    }
#pragma unroll
    for (int i = 0; i < 32; ++i) s += v[i];
    const float mean = wave_sum(s) * (1.f / 2048.f);
    float q = 0.f;
#pragma unroll
    for (int i = 0; i < 32; ++i) { v[i] -= mean; q += v[i] * v[i]; }
    const float rstd = rsqrtf(wave_sum(q) * (1.f / 2048.f) + 1e-5f);
#pragma unroll
    for (int i = 0; i < 4; ++i) {
      const int c0 = i * 512 + lane * 8;
      float o[8];
#pragma unroll
      for (int jj = 0; jj < 8; ++jj) o[jj] = v[i * 8 + jj] * rstd * (SPF + SP_LN1G)[c0 + jj] + (SPF + SP_LN1B)[c0 + jj];
      *(float4*)(row + c0) = float4{o[0], o[1], o[2], o[3]};
      *(float4*)(row + c0 + 4) = float4{o[4], o[5], o[6], o[7]};
      uint4 w;
      w.x = pack2(o[0], o[1]); w.y = pack2(o[2], o[3]); w.z = pack2(o[4], o[5]); w.w = pack2(o[6], o[7]);
      *(uint4*)(h1b + (size_t)r * 2048 + c0) = w;
    }
  }
}

__device__ void phase7(const Params& P, char* smem) {
  char* ws = P.ws;
  const u16* h1b = (const u16*)(ws + OFF_A0);
  const u16* wt = (const u16*)(ws + OFF_WQ);
  const u16* keysb = (const u16*)(ws + OFF_KEYS);
  float* tops = (float*)(ws + OFF_A4);
  int* topi = (int*)(ws + OFF_A4 + A4_TOPI);
  const int tid = threadIdx.x, lane = tid & 63, wave = tid >> 6, wm = wave >> 1, wn = wave & 1;
  for (int tile = blockIdx.x; tile < 64 * 16; tile += P.nblk) {
    const int mt = tile & 63, nt = tile >> 6;
    const int m0 = mt * 128, n0 = nt * 128;
    f32x4 acc[4][4];
    zero_acc(acc);
    gemm_mainloop(acc, h1b + (size_t)m0 * 2048, 2048, wt + (size_t)n0 * 2048, 2048, 2048, smem);
    u16* Q = (u16*)smem;
    u16* Kt = Q + 128 * 136;
    EPIV_BEGIN EPIV_INNER
      *(uint2*)(Q + lrow * 136 + lcol0) = pack4(acc[mi][ni]);
    EPIV_INNER_END EPIV_END
    {
      const u16* kb = keysb + (size_t)nt * 128 * 128;
#pragma unroll 4
      for (int i = 0; i < 8; ++i) {
        const int id = tid + i * 256;
        const int row = id >> 4, ch = id & 15;
        *(uint4*)(Kt + row * 136 + ch * 8) = *(const uint4*)(kb + row * 128 + ch * 8);
      }
    }
    __syncthreads();
    zero_acc(acc);
#pragma unroll
    for (int ks = 0; ks < 4; ++ks) {
      bf16x8 af[4], bfr[4];
#pragma unroll
      for (int mi = 0; mi < 4; ++mi)
        af[mi] = *(const bf16x8*)(Q + (wm * 64 + mi * 16 + (lane & 15)) * 136 + ks * 32 + (lane >> 4) * 8);
#pragma unroll
      for (int ni = 0; ni < 4; ++ni)
        bfr[ni] = *(const bf16x8*)(Kt + (wn * 64 + ni * 16 + (lane & 15)) * 136 + ks * 32 + (lane >> 4) * 8);
#pragma unroll
      for (int mi = 0; mi < 4; ++mi)
#pragma unroll
        for (int ni = 0; ni < 4; ++ni) acc[mi][ni] = mfma16(bfr[ni], af[mi], acc[mi][ni]);
    }
    __syncthreads();
    float* Sc = (float*)smem;
    EPIV_BEGIN EPIV_INNER
      *(f32x4*)(Sc + lrow * 132 + lcol0) = acc[mi][ni];
    EPIV_INNER_END EPIV_END
    __syncthreads();
    {
      const int row = tid >> 1, half = tid & 1;
      float* r = Sc + row * 132 + half * 64;
      const size_t ob = ((size_t)(m0 + row) * 16 + nt) * 16;
      for (int k = 0; k < 16; ++k) {
        float best = -3.0e38f;
        int bi = 0;
#pragma unroll 4
        for (int c4 = 0; c4 < 16; ++c4) {
          const f32x4 v4 = *(const f32x4*)(r + c4 * 4);
#pragma unroll
          for (int j = 0; j < 4; ++j)
            if (v4[j] > best) { best = v4[j]; bi = c4 * 4 + j; }
        }
        const float obest = dpp_f<0xB1>(best);
        const int obi = __builtin_amdgcn_update_dpp(0, bi, 0xB1, 0xF, 0xF, false);
        const int mycol = half * 64 + bi, ocol = (half ^ 1) * 64 + obi;
        const bool mine = (best > obest) || (best == obest && mycol < ocol);
        if (half == 0) {
          tops[ob + k] = mine ? best : obest;
          topi[ob + k] = mine ? mycol : ocol;
        }
        if (mine) r[bi] = -3.0e38f;
      }
    }
    __syncthreads();
  }
}

__device__ void phase9(const Params& P, char* smem) {
  char* ws = P.ws;
  const float* h1 = (const float*)(ws + OFF_A2);
  const float* tops = (const float*)(ws + OFF_A4);
  const int* topi = (const int*)(ws + OFF_A4 + A4_TOPI);
  const unsigned char* Ub = (const unsigned char*)(ws + OFF_UB);
  const unsigned char* Vb = (const unsigned char*)(ws + OFF_VB);
  float* h2 = (float*)(ws + OFF_A3);
  u16* h2b = (u16*)(ws + OFF_A4 + A4_H2B);
  const int tid = threadIdx.x, lane = tid & 63, wave = tid >> 6;
  int ca, cb;
  {
    const int l = lane;
    if (l < 16) { ca = 0; cb = l; }
    else if (l < 24) { ca = 1; cb = l - 16; }
    else if (l < 29) { ca = 2; cb = l - 24; }
    else if (l < 33) { ca = 3; cb = l - 29; }
    else if (l < 36) { ca = 4; cb = l - 33; }
    else if (l < 38) { ca = 5; cb = l - 36; }
    else if (l < 40) { ca = 6; cb = l - 38; }
    else if (l < 42) { ca = 7; cb = l - 40; }
    else if (l < 50) { ca = l - 34; cb = 0; }
    else { ca = 0; cb = 0; }
  }
  const bool cvalid = lane < 50;
  f32x4* xs = (f32x4*)(smem + wave * 8192);
  const __amdgpu_buffer_rsrc_t rsU = __builtin_amdgcn_make_buffer_rsrc((void*)Ub, 0, 0x7fffffff, 0x00020000);
  const __amdgpu_buffer_rsrc_t rsV = __builtin_amdgcn_make_buffer_rsrc((void*)Vb, 0, 0x7fffffff, 0x00020000);
  for (int t = blockIdx.x * 4 + wave; t < T_TOK; t += P.nblk * 4) {
    {
      const float* row = h1 + (size_t)t * 2048;
#pragma unroll
      for (int i = 0; i < 2; ++i)
#pragma unroll
        for (int k = 0; k < 4; ++k) xs[(i * 4 + k) * 64 + lane] = *(const f32x4*)(row + i * 1024 + lane * 16 + k * 4);
    }
    float sc0 = 0.f, sc1 = 0.f;
    int id0 = 0, id1 = 0;
#pragma unroll
    for (int hs = 0; hs < 2; ++hs) {
#pragma unroll 1
      for (int hq = 0; hq < 4; ++hq) {
        const int head = hs * 4 + hq;
        const size_t ob = ((size_t)t * 16 + head * 2) * 16;
        float val = -3.0e38f;
        int eid = 0;
        if (cvalid) {
          val = tops[ob + ca] + tops[ob + 16 + cb];
          eid = topi[ob + ca] * 128 + topi[ob + 16 + cb];
        }
#pragma unroll 1
        for (int k = 0; k < 16; ++k) {
          const float m = wave_max(val);
          const unsigned long long mask = __ballot(val == m);
          const int win = __ffsll((long long)mask) - 1;
          const int widx = __builtin_amdgcn_readlane(eid, win);
          if (lane == hq * 16 + k) {
            if (hs == 0) { sc0 = m; id0 = widx; } else { sc1 = m; id1 = widx; }
          }
          if (lane == win) val = -3.0e38f;
        }
      }
    }
    float g0, g1;
    {
      const float mx0 = row_max(sc0), mx1 = row_max(sc1);
      const float e0 = __expf(sc0 - mx0), e1 = __expf(sc1 - mx1);
      const float s0 = row_sum(e0), s1 = row_sum(e1);
      g0 = e0 / s0; g1 = e1 / s1;
    }
    float acc[32];
#pragma unroll
    for (int i = 0; i < 32; ++i) acc[i] = 0.f;
    u32x4v U00, U01, U10, U11, U20, U21, U30, U31, V00, V01, V10, V11, V20, V21, V30, V31;
#define P9_LDU(S, idv) { const int so_ = (idv) * 2048; U##S##0 = __builtin_amdgcn_raw_buffer_load_b128(rsU, lane * 16, so_, 0); U##S##1 = __builtin_amdgcn_raw_buffer_load_b128(rsU, lane * 16 + 1024, so_, 0); }
#define P9_LDV(S, idv) { const int so_ = (idv) * 2048; V##S##0 = __builtin_amdgcn_raw_buffer_load_b128(rsV, lane * 16, so_, 0); V##S##1 = __builtin_amdgcn_raw_buffer_load_b128(rsV, lane * 16 + 1024, so_, 0); }
#define P9_DOT8(W, XB, sacc) {                                                         \
      _Pragma("unroll") for (int k = 0; k < 4; ++k) {                                  \
        const f32x2 lo = __builtin_amdgcn_cvt_pk_f32_fp8((int)(W)[k], false);          \
        const f32x2 hi = __builtin_amdgcn_cvt_pk_f32_fp8((int)(W)[k], true);           \
        const f32x4 xv = xs[((XB) + k) * 64 + lane];                                   \
        sacc##A = f32x2{xv[0], xv[1]} * lo + sacc##A;                                  \
        sacc##B = f32x2{xv[2], xv[3]} * hi + sacc##B;                                  \
      } }
#define P9_AXPY8(W, AB, a_) {                                                          \
      _Pragma("unroll") for (int k = 0; k < 4; ++k) {                                  \
        const f32x2 lo = __builtin_amdgcn_cvt_pk_f32_fp8((int)(W)[k], false);          \
        const f32x2 hi = __builtin_amdgcn_cvt_pk_f32_fp8((int)(W)[k], true);           \
        acc[(AB) + k * 4 + 0] += a_ * lo[0]; acc[(AB) + k * 4 + 1] += a_ * lo[1];      \
        acc[(AB) + k * 4 + 2] += a_ * hi[0]; acc[(AB) + k * 4 + 3] += a_ * hi[1];      \
      } }
#define P9_STEP(S, e_) {                                                               \
      const int e = (e_);                                                              \
      f32x2 d_A = {0.f, 0.f}, d_B = {0.f, 0.f};                                        \
      P9_DOT8(U##S##0, 0, d_)                                                          \
      P9_DOT8(U##S##1, 4, d_)                                                          \
      float d_ = (d_A[0] + d_A[1]) + (d_B[0] + d_B[1]);                                \
      const float gt_ = (e < 64) ? rdl(g0, e & 63) : rdl(g1, e & 63);                  \
      const int en_ = (e + 4) & 127;                                                   \
      const int idn_ = (en_ < 64) ? __builtin_amdgcn_readlane(id0, en_ & 63) : __builtin_amdgcn_readlane(id1, en_ & 63); \
      __builtin_amdgcn_sched_barrier(0);                                               \
      P9_LDU(S, idn_)                                                                  \
      __builtin_amdgcn_sched_barrier(0);                                               \
      d_ = wave_sum(d_);                                                               \
      const float a_ = gelu_tanh(d_ * (1.f / U_SCALE)) * gt_ * (1.f / V_SCALE);        \
      P9_AXPY8(V##S##0, 0, a_)                                                         \
      P9_AXPY8(V##S##1, 16, a_)                                                        \
      __builtin_amdgcn_sched_barrier(0);                                               \
      P9_LDV(S, idn_)                                                                  \
      __builtin_amdgcn_sched_barrier(0);                                               \
    }
    {
      const int i0_ = __builtin_amdgcn_readlane(id0, 0), i1_ = __builtin_amdgcn_readlane(id0, 1), i2_ = __builtin_amdgcn_readlane(id0, 2), i3_ = __builtin_amdgcn_readlane(id0, 3);
      P9_LDU(0, i0_) P9_LDV(0, i0_) P9_LDU(1, i1_) P9_LDV(1, i1_) P9_LDU(2, i2_) P9_LDV(2, i2_) P9_LDU(3, i3_) P9_LDV(3, i3_)
    }
#pragma unroll 1
    for (int eb = 0; eb < 128; eb += 4) {
      P9_STEP(0, eb)
      P9_STEP(1, eb + 1)
      P9_STEP(2, eb + 2)
      P9_STEP(3, eb + 3)
    }
#undef P9_LDU
#undef P9_LDV
#undef P9_DOT8
#undef P9_AXPY8
#undef P9_STEP
    float s = 0.f;
#pragma unroll
    for (int jq = 0; jq < 8; ++jq) {
      const f32x4 xv = xs[jq * 64 + lane];
#pragma unroll
      for (int c = 0; c < 4; ++c) { acc[jq * 4 + c] = DN_ALPHA * xv[c] + acc[jq * 4 + c]; s += acc[jq * 4 + c]; }
    }
    const float mean = wave_sum(s) * (1.f / 2048.f);
    float qv = 0.f;
#pragma unroll
    for (int i = 0; i < 32; ++i) { acc[i] -= mean; qv += acc[i] * acc[i]; }
    const float rstd = rsqrtf(wave_sum(qv) * (1.f / 2048.f) + 1e-5f);
    const int lz9 = lane + opaque0();
#pragma unroll
    for (int i = 0; i < 2; ++i) {
      const int c0 = i * 1024 + lz9 * 16;
      float o[16];
#pragma unroll
      for (int k = 0; k < 4; ++k) {
        const f32x4 gg = *(const f32x4*)(SPF + SP_LN2G + c0 + k * 4);
        const f32x4 bb = *(const f32x4*)(SPF + SP_LN2B + c0 + k * 4);
#pragma unroll
        for (int j = 0; j < 4; ++j) o[k * 4 + j] = acc[i * 16 + k * 4 + j] * rstd * gg[j] + bb[j];
        *(float4*)(h2 + (size_t)t * 2048 + c0 + k * 4) = float4{o[k * 4], o[k * 4 + 1], o[k * 4 + 2], o[k * 4 + 3]};
      }
      uint4 w0, w1;
      w0.x = pack2(o[0], o[1]); w0.y = pack2(o[2], o[3]); w0.z = pack2(o[4], o[5]); w0.w = pack2(o[6], o[7]);
      w1.x = pack2(o[8], o[9]); w1.y = pack2(o[10], o[11]); w1.z = pack2(o[12], o[13]); w1.w = pack2(o[14], o[15]);
      *(uint4*)(h2b + (size_t)t * 2048 + c0) = w0;
      *(uint4*)(h2b + (size_t)t * 2048 + c0 + 8) = w1;
    }
  }
}

__device__ void phase10(const Params& P, char* smem) {
  char* ws = P.ws;
  const u16* h2b = (const u16*)(ws + OFF_A4 + A4_H2B);
  const float* h2 = (const float*)(ws + OFF_A3);
  const u16* pb = (const u16*)(ws + OFF_PB);
  const u16* wg = (const u16*)(ws + OFF_WPG);
  const u16* wp = (const u16*)(ws + OFF_WPP);
  float* ppb = (float*)(ws + OFF_A2);
  const int tid = threadIdx.x, lane = tid & 63, wave = tid >> 6, wm = wave >> 1, wn = wave & 1;
  for (int tile = blockIdx.x; tile < 32 * 16; tile += P.nblk) {
    const int mt = tile & 31, nt = tile >> 5;
    const int m0 = mt * 256, n0 = nt * 128;
    f32x4 acc[8][4];
    zero_acc8(acc);
    gemm_mainloop_big(acc, pb + (size_t)m0 * 256, 256, wp + (size_t)n0 * 256, 256, 256, smem);
    EPIV8_BEGIN EPIV8_INNER
      *(f32x4*)(ppb + (size_t)(m0 + lrow) * 2048 + n0 + lcol0) = acc[mi][ni];
    EPIV_INNER_END EPIV_END
    zero_acc8(acc);
    gemm_mainloop_big(acc, h2b + (size_t)m0 * 2048, 2048, wg + (size_t)n0 * 2048, 2048, 2048, smem);
    EPIV8_BEGIN
      f32x4 hv[4], pv[4];
      EPIV8_INNER
        hv[ni] = *(const f32x4*)(h2 + (size_t)(m0 + lrow) * 2048 + n0 + lcol0);
        pv[ni] = *(const f32x4*)(ppb + (size_t)(m0 + lrow) * 2048 + n0 + lcol0);
      EPIV_INNER_END
      EPIV_MID
      EPIV8_INNER
        *(f32x4*)(P.out + (size_t)(m0 + lrow) * 2048 + n0 + lcol0) = hv[ni] + sigmoid4(acc[mi][ni]) * pv[ni];
      EPIV_INNER_END
    EPIV_END
  }
}

constexpr int N_PHASES = 11;


#define XB_TMO      128
#define XB_XCNT(j)  (256  + 64 * (j))
#define XB_XSUB(j)  (1280 + 64 * (j))
#define XB_XGEN(j)  (2304 + 64 * (j))
#define XB_TOP      3328
#define XB_TOPGEN   3392
#define XCD_BAR_WORDS 3456
#define XB_SPIN_CAP (1u << 18)
#define LAS __attribute__((address_space(3)))
__device__ __forceinline__ unsigned xb_ld(unsigned* p)              { return __hip_atomic_load(p, __ATOMIC_RELAXED, __HIP_MEMORY_SCOPE_AGENT); }
__device__ __forceinline__ unsigned xb_add(unsigned* p, unsigned v) { return __hip_atomic_fetch_add(p, v, __ATOMIC_RELAXED, __HIP_MEMORY_SCOPE_AGENT); }
__device__ __forceinline__ unsigned xb_xcc_id() { return (unsigned)__builtin_amdgcn_s_getreg((3 << 11) | 20) & 0xFu; }
#define XB_SPIN(cond, bar) do { unsigned _sp = 0; while (cond) { __builtin_amdgcn_s_sleep(1); \
    if ((++_sp & 255u) == 0u) { if (xb_ld(&(bar)[XB_TMO])) break; if (_sp > XB_SPIN_CAP) { atomicAdd(&(bar)[XB_TMO], 1u); break; } } } } while (0)
struct XcdBarrier { unsigned* bar; unsigned x; volatile LAS unsigned* st; unsigned grid; };
__device__ __forceinline__ XcdBarrier xcd_barrier_post(unsigned* bar, volatile LAS unsigned* st) {
  XcdBarrier b; b.bar = bar; b.x = xb_xcc_id(); b.st = st; b.grid = 0u;
  if (threadIdx.x == 0) (void)xb_add(&bar[XB_XCNT(b.x)], 1u);
  return b;
}
__device__ __forceinline__ void xcd_barrier_complete(unsigned* bar, unsigned x, unsigned& nloc, unsigned& nx, const unsigned xb_grid) {
  const unsigned G = xb_grid;
  unsigned sum, cnt, mine, sp = 0u;
  for (;;) {
    sum = 0u; cnt = 0u; mine = 0u;
#pragma unroll
    for (unsigned j = 0; j < 16; ++j) { const unsigned c = xb_ld(&bar[XB_XCNT(j)]); sum += c; cnt += (c > 0u) ? 1u : 0u; mine = (j == x) ? c : mine; }
    if (sum == G) break;
    __builtin_amdgcn_s_sleep(1);
    if ((++sp & 255u) == 0u) { if (xb_ld(&bar[XB_TMO])) break; if (sp > XB_SPIN_CAP) { atomicAdd(&bar[XB_TMO], 1u); break; } }
  }
  nloc = mine > 0u ? mine : 1u; nx = cnt > 0u ? cnt : 1u;
}
__device__ __forceinline__ void xcd_barrier(const XcdBarrier& b) {
  asm volatile("s_waitcnt vmcnt(0)" ::: "memory");
  __syncthreads();
  if (threadIdx.x == 0) {
    unsigned* bar = b.bar;
    __builtin_amdgcn_s_waitcnt(0);
    unsigned nloc = b.st[0], nx = b.st[1];
    if (nloc == 0u) { xcd_barrier_complete(bar, b.x, nloc, nx, b.grid); b.st[0] = nloc; b.st[1] = nx; }
    const unsigned old = xb_add(&bar[XB_XSUB(b.x)], 1u);
    const unsigned gen = old / nloc;
    if (old + 1u == (gen + 1u) * nloc) {
      __builtin_amdgcn_fence(__ATOMIC_RELEASE, "agent");
      asm volatile("s_waitcnt vmcnt(0)" ::: "memory");
      const unsigned og = xb_add(&bar[XB_TOP], 1u);
      const unsigned tg = og / nx;
      if (og + 1u == (tg + 1u) * nx) xb_add(&bar[XB_TOPGEN], 1u);
      else XB_SPIN(xb_ld(&bar[XB_TOPGEN]) == tg, bar);
      __builtin_amdgcn_fence(__ATOMIC_ACQUIRE, "agent");
      xb_add(&bar[XB_XGEN(b.x)], 1u);
      asm volatile("s_waitcnt vmcnt(0)" ::: "memory");
    } else {
      XB_SPIN(xb_ld(&bar[XB_XGEN(b.x)]) == gen, bar);
      __builtin_amdgcn_fence(__ATOMIC_ACQUIRE, "agent");
      asm volatile("s_waitcnt vmcnt(0)" ::: "memory");
    }
  }
  __syncthreads();
}

template <int MODE>
__global__ void __launch_bounds__(256, 2) mega(Params P) {
  __shared__ __attribute__((aligned(16))) char smem[SMEM_BYTES];
  __shared__ uint4 xb_words;
  if (MODE < 0) {
    if (threadIdx.x == 0) xb_words = make_uint4(0u, 0u, 0u, 0u);
    __syncthreads();
    (void)xcd_barrier_post((unsigned*)(P.ws + OFF_BAR), (volatile LAS unsigned*)&xb_words);
  }
#define XB_HERE() XcdBarrier{(unsigned*)(P.ws + OFF_BAR), xb_xcc_id(), (volatile LAS unsigned*)&xb_words, (unsigned)P.nblk}
#define RUN_PHASE(n, fn)                                              \
  if (MODE < 0 || MODE == n) {                                        \
    fn(P, smem);                                                      \
    if (MODE < 0 && n + 1 < N_PHASES) {                               \
      if (P.ws == nullptr) cg::this_grid().sync(); else xcd_barrier(XB_HERE()); \
    }                                                                 \
  }
  RUN_PHASE(0, phase0)
  RUN_PHASE(1, phase1)
  RUN_PHASE(2, phase1c)
  RUN_PHASE(3, phase2)
  RUN_PHASE(4, phase3)
  RUN_PHASE(5, phase4b)
  RUN_PHASE(6, phase5)
  RUN_PHASE(7, phase6)
  RUN_PHASE(8, phase7)
  RUN_PHASE(9, phase9)
  RUN_PHASE(10, phase10)
}

template <int PH>
static void launch_phase(Params P, hipStream_t stream) {
  P.nblk = 512;
  hipLaunchKernelGGL(mega<PH>, dim3(512), dim3(256), 0, stream, P);
}

extern "C" void kernel_launch(void* const* d_in, const int* in_sizes, int n_in, void* d_out, int out_size,
                              void* d_ws, size_t ws_size, hipStream_t stream) {
  Params P{};
  const float** pp = (const float**)&P;
  for (int i = 0; i < 30; ++i) pp[i] = (const float*)d_in[i];
  P.out = (float*)d_out;
  P.ws = (char*)d_ws;
  if (ws_size < OFF_END2) {
    fprintf(stderr, "workspace too small: %zu < %zu\n", ws_size, (size_t)OFF_END2);
    return;
  }
#if COOP_LAUNCH
  static int grid_blocks = 0;
  if (!grid_blocks) {
    int dev = 0, cus = 0, per_cu = 0;
    hipGetDevice(&dev);
    hipDeviceGetAttribute(&cus, hipDeviceAttributeMultiprocessorCount, dev);
    hipOccupancyMaxActiveBlocksPerMultiprocessor(&per_cu, mega<-1>, 256, 0);
    grid_blocks = cus * per_cu;
  }
  hipMemsetAsync((char*)d_ws + OFF_BAR, 0, XCD_BAR_WORDS * 4 + 256, stream);
  P.nblk = grid_blocks;
  void* args[] = {&P};
  hipError_t e = hipLaunchCooperativeKernel((void*)mega<-1>, dim3(grid_blocks), dim3(256), args, 0, stream);
  if (e != hipSuccess) fprintf(stderr, "cooperative launch failed: %s (grid %d)\n", hipGetErrorString(e), grid_blocks);
#else
  launch_phase<0>(P, stream);
  launch_phase<1>(P, stream);
  launch_phase<2>(P, stream);
  launch_phase<3>(P, stream);
  launch_phase<4>(P, stream);
  launch_phase<5>(P, stream);
  launch_phase<6>(P, stream);
  launch_phase<7>(P, stream);
  launch_phase<8>(P, stream);
  launch_phase<9>(P, stream);
  launch_phase<10>(P, stream);
#endif
}
```
